# Optimizing an MI355X kernel written in HIP

```python
import jax, jax.numpy as jnp
from jax import lax
import numpy as np

D_MODEL = 2048
BATCH = 16
SEQ = 256
DEPTH = 1
DEC_BATCH = 2
DEC_SEQ = 4096
PAST_LEN = 256

GRID_W = 64
HEAD_DIM = 128
H_RET = 8
H_ATT = 8
KV_HEADS = 2
GQA_REP = H_ATT // KV_HEADS
RET_WIDTH = H_RET * HEAD_DIM
ATT_WIDTH = H_ATT * HEAD_DIM
KV_WIDTH = KV_HEADS * HEAD_DIM
IN_SPLITS = (RET_WIDTH, 2 * RET_WIDTH, 3 * RET_WIDTH, 4 * RET_WIDTH,
             4 * RET_WIDTH + ATT_WIDTH, 4 * RET_WIDTH + ATT_WIDTH + KV_WIDTH)
IN_COLS = 4 * RET_WIDTH + ATT_WIDTH + 2 * KV_WIDTH
RET_CHUNK = 128
Q_BLOCK = 128
ROPE_BASE = 10000.0
ROPE_AXIS_DIM = HEAD_DIM // 2
N_KEYS = 128
N_EXPERTS = N_KEYS * N_KEYS
PEER_HEADS = 8
PEER_TOPK = 16
PEER_QDIM = 256
PEER_SUBDIM = PEER_QDIM // 2
PEER_TOK_BLOCK = 128
N_MOD = 6
NORM_EPS = 1e-5
DN_ALPHA = (2.0 * DEPTH) ** 0.25
DN_BETA = (8.0 * DEPTH) ** -0.25

kernel_name = "hybrid_retention_gqa_peer_dit_step"


def _layer_norm(x, g, b):
    x32 = x.astype(jnp.float32)
    mu = x32.mean(-1, keepdims=True)
    var = jnp.square(x32 - mu).mean(-1, keepdims=True)
    return ((x32 - mu) * lax.rsqrt(var + NORM_EPS) * g + b).astype(x.dtype)


def _rms_heads(x, g):
    x32 = x.astype(jnp.float32)
    return (x32 * lax.rsqrt(jnp.mean(x32 * x32, -1, keepdims=True) + NORM_EPS) * g).astype(x.dtype)


def _ada_modulation(cond, w_ada, b_ada):
    m = jax.nn.silu(cond) @ w_ada + b_ada
    return jnp.split(m[:, None, :], N_MOD, axis=-1)


def _axial_rope(x, n_tokens):
    rows = n_tokens // GRID_W
    row = jnp.repeat(jnp.arange(rows, dtype=jnp.float32), GRID_W)
    col = jnp.tile(jnp.arange(GRID_W, dtype=jnp.float32), rows)
    inv_freq = ROPE_BASE ** (-jnp.arange(0, ROPE_AXIS_DIM, 2, dtype=jnp.float32) / ROPE_AXIS_DIM)
    ang_r = row[:, None] * inv_freq
    ang_c = col[:, None] * inv_freq
    ang = jnp.concatenate([ang_r, ang_r, ang_c, ang_c], -1)[None, :, None, :]
    half = ROPE_AXIS_DIM // 2
    x1 = x[..., :half]
    x2 = x[..., half:ROPE_AXIS_DIM]
    x3 = x[..., ROPE_AXIS_DIM:ROPE_AXIS_DIM + half]
    x4 = x[..., ROPE_AXIS_DIM + half:]
    rot = jnp.concatenate([-x2, x1, -x4, x3], -1)
    return (x * jnp.cos(ang) + rot * jnp.sin(ang)).astype(x.dtype)


def _retention_dir(q, k, v, log_gamma, s0):
    b, h, L, dk = q.shape
    dv = v.shape[-1]
    nc = L // RET_CHUNK
    qc = q.reshape(b, h, nc, RET_CHUNK, dk)
    kc = k.reshape(b, h, nc, RET_CHUNK, dk)
    vc = v.reshape(b, h, nc, RET_CHUNK, dv)
    pos = jnp.arange(RET_CHUNK, dtype=jnp.float32)
    lg = log_gamma[:, None]
    diff = pos[:, None] - pos[None, :]
    dmask = jnp.where(diff >= 0, jnp.exp(lg[:, :, None] * jnp.maximum(diff, 0.0)), 0.0)
    scores = jnp.einsum('bhcid,bhcjd->bhcij', qc, kc) * dmask[None, :, None]
    intra = jnp.einsum('bhcij,bhcje->bhcie', scores, vc)
    zeta = jnp.exp(lg * (RET_CHUNK - 1.0 - pos))
    kv = jnp.einsum('bhcjd,bhcje->cbhde', kc * zeta[None, :, None, :, None], vc)
    gamma_c = jnp.exp(log_gamma * RET_CHUNK)[None, :, None, None]

    def step(s, kv_c):
        return gamma_c * s + kv_c, s

    s_final, s_prev = lax.scan(step, s0, kv)
    xi = jnp.exp(lg * (pos + 1.0))
    cross = jnp.einsum('bhcid,cbhde->bhcie', qc * xi[None, :, None, :, None], s_prev)
    return (intra + cross).reshape(b, h, L, dv), s_final


def _block_attention(q, k, v):
    b, L = q.shape[:2]
    nb = L // Q_BLOCK
    qb = q.reshape(b, nb, Q_BLOCK, KV_HEADS, GQA_REP, HEAD_DIM).transpose(1, 0, 2, 3, 4, 5)
    scale = HEAD_DIM ** -0.5

    def one_block(qblk):
        s = jnp.einsum('bqgrd,bkgd->bgrqk', qblk, k).astype(jnp.float32) * scale
        p = jax.nn.softmax(s, axis=-1).astype(v.dtype)
        return jnp.einsum('bgrqk,bkgd->bqgrd', p, v)

    o = lax.map(one_block, qb)
    return o.transpose(1, 0, 2, 3, 4, 5).reshape(b, L, ATT_WIDTH)


def _mixing(h, w_in, decay_logit, gn_g, qn_g, kn_g, w_o, ctx):
    b, L, _ = h.shape
    proj = h @ w_in
    q_r, k_r, v_r, g_r, q_a, k_a, v_a = jnp.split(proj, IN_SPLITS, axis=-1)

    def heads(t):
        return t.reshape(b, L, -1, HEAD_DIM).transpose(0, 2, 1, 3).astype(jnp.float32)

    log_gamma = jax.nn.log_sigmoid(decay_logit.astype(jnp.float32))
    if ctx is None:
        s0_f = jnp.zeros((b, H_RET, HEAD_DIM, HEAD_DIM), jnp.float32)
        s0_b = s0_f
    else:
        s0_f = ctx[0].astype(jnp.float32)
        s0_b = ctx[1].astype(jnp.float32)

    qr = heads(q_r)
    kr = heads(k_r) * HEAD_DIM ** -0.5
    vr = heads(v_r)
    o_f, s_f = _retention_dir(qr, kr, vr, log_gamma[0], s0_f)
    o_b, s_b = _retention_dir(jnp.flip(qr, 2), jnp.flip(kr, 2), jnp.flip(vr, 2), log_gamma[1], s0_b)
    o_r = o_f + jnp.flip(o_b, 2)
    mu = o_r.mean(-1, keepdims=True)
    var = jnp.square(o_r - mu).mean(-1, keepdims=True)
    o_r = ((o_r - mu) * lax.rsqrt(var + NORM_EPS)).transpose(0, 2, 1, 3).reshape(b, L, RET_WIDTH)
    o_r = (o_r * gn_g * jax.nn.silu(g_r.astype(jnp.float32))).astype(h.dtype)

    qa = _rms_heads(q_a.reshape(b, L, H_ATT, HEAD_DIM), qn_g)
    ka = _rms_heads(k_a.reshape(b, L, KV_HEADS, HEAD_DIM), kn_g)
    va = v_a.reshape(b, L, KV_HEADS, HEAD_DIM)
    if ctx is None:
        k_all, v_all = ka, va
        new_ctx = (jnp.stack([s_f, s_b], axis=1), ka, va)
    else:
        qa = _axial_rope(qa, L)
        ka = _axial_rope(ka, L)
        k_all = jnp.concatenate([ctx[2].astype(ka.dtype), ka], axis=1)
        v_all = jnp.concatenate([ctx[3].astype(va.dtype), va], axis=1)
        new_ctx = None
    o_a = _block_attention(qa.reshape(b, L, KV_HEADS, GQA_REP, HEAD_DIM), k_all, v_all)

    out = jnp.concatenate([o_r, o_a.astype(h.dtype)], axis=-1) @ w_o
    return out, new_ctx


def _peer(h, w_q, sub_keys, u_tab, v_tab):
    b, L, d = h.shape
    T = b * L
    x = h.reshape(T, d)
    q = (x @ w_q).reshape(T, PEER_HEADS, 2, PEER_SUBDIM)
    s = jnp.einsum('thpd,hpnd->thpn', q, sub_keys).astype(jnp.float32)
    top_s, top_i = lax.top_k(s, PEER_TOPK)
    cand_s = (top_s[:, :, 0, :, None] + top_s[:, :, 1, None, :]).reshape(T, PEER_HEADS, PEER_TOPK * PEER_TOPK)
    cand_i = (top_i[:, :, 0, :, None] * N_KEYS + top_i[:, :, 1, None, :]).reshape(T, PEER_HEADS, PEER_TOPK * PEER_TOPK)
    best_s, best_pos = lax.top_k(cand_s, PEER_TOPK)
    idx = jnp.take_along_axis(cand_i, best_pos, axis=-1)
    gate = jax.nn.softmax(best_s, axis=-1)
    nb = T // PEER_TOK_BLOCK

    def one_block(args):
        xt, it, gt = args
        act = jax.nn.gelu(jnp.einsum('thkd,td->thk', u_tab[it], xt).astype(jnp.float32), approximate=False)
        w = (gt * act).astype(v_tab.dtype)
        return jnp.einsum('thk,thkd->td', w, v_tab[it])

    out = lax.map(one_block, (x.reshape(nb, PEER_TOK_BLOCK, d),
                              idx.reshape(nb, PEER_TOK_BLOCK, PEER_HEADS, PEER_TOPK),
                              gate.reshape(nb, PEER_TOK_BLOCK, PEER_HEADS, PEER_TOPK)))
    return out.reshape(b, L, d)


def _layer(x, cond, p, ctx):
    (w_ada, b_ada, w_in, decay_logit, gn_g, qn_g, kn_g, w_o,
     ln1_g, ln1_b, pw_q, p_keys, p_u, p_v, ln2_g, ln2_b) = p
    sh1, sc1, g1, sh2, sc2, g2 = _ada_modulation(cond, w_ada, b_ada)
    h = x * (1.0 + sc1) + sh1
    mix, new_ctx = _mixing(h, w_in, decay_logit, gn_g, qn_g, kn_g, w_o, ctx)
    x = _layer_norm(DN_ALPHA * x + g1 * mix, ln1_g, ln1_b)
    h = x * (1.0 + sc2) + sh2
    x = _layer_norm(DN_ALPHA * x + g2 * _peer(h, pw_q, p_keys, p_u, p_v), ln2_g, ln2_b)
    return x, new_ctx


def setup_inputs(seed: int = 0) -> dict:
    key = jax.random.key(seed)
    ks = jax.random.split(key, 24)
    d = D_MODEL

    def nrm(k, shape, s):
        return jax.random.normal(k, shape, jnp.float32) * s

    col_scale = jnp.concatenate([
        jnp.ones((2 * RET_WIDTH,), jnp.float32),
        jnp.full((RET_WIDTH,), DN_BETA, jnp.float32),
        jnp.ones((RET_WIDTH + ATT_WIDTH + KV_WIDTH,), jnp.float32),
        jnp.full((KV_WIDTH,), DN_BETA, jnp.float32)])
    gam = 1.0 - 2.0 ** (-5.0 - jnp.arange(H_RET, dtype=jnp.float32))
    logit = jnp.log(gam) - jnp.log1p(-gam)
    return {
        "x_prompt": nrm(ks[0], (BATCH, SEQ, d), 1.0),
        "x_sample": nrm(ks[1], (DEC_BATCH, DEC_SEQ, d), 1.0),
        "state_ret": nrm(ks[2], (DEC_BATCH, DEPTH, 2, H_RET, HEAD_DIM, HEAD_DIM), 0.5),
        "cache_k": nrm(ks[3], (DEC_BATCH, DEPTH, PAST_LEN, KV_HEADS, HEAD_DIM), 1.0),
        "cache_v": nrm(ks[4], (DEC_BATCH, DEPTH, PAST_LEN, KV_HEADS, HEAD_DIM), 1.0),
        "c": nrm(ks[5], (DEC_BATCH, d), 1.0),
        "c_ctx": nrm(ks[6], (d,), 1.0),
        "w_ada": nrm(ks[7], (DEPTH, d, N_MOD * d), 0.5 * d ** -0.5),
        "b_ada": nrm(ks[8], (DEPTH, N_MOD * d), 0.02),
        "w_in": nrm(ks[9], (DEPTH, d, IN_COLS), d ** -0.5) * col_scale,
        "ret_decay_logit": jnp.broadcast_to(logit, (DEPTH, 2, H_RET)) + nrm(ks[10], (DEPTH, 2, H_RET), 0.1),
        "ret_gn_g": 1.0 + nrm(ks[11], (DEPTH, RET_WIDTH), 0.02),
        "q_norm_g": 1.0 + nrm(ks[12], (DEPTH, HEAD_DIM), 0.02),
        "k_norm_g": 1.0 + nrm(ks[13], (DEPTH, HEAD_DIM), 0.02),
        "w_o": nrm(ks[14], (DEPTH, d, d), DN_BETA * d ** -0.5),
        "ln1_g": 1.0 + nrm(ks[15], (DEPTH, d), 0.02),
        "ln1_b": nrm(ks[16], (DEPTH, d), 0.02),
        "peer_w_q": nrm(ks[17], (DEPTH, d, PEER_HEADS * PEER_QDIM), d ** -0.5),
        "peer_sub_keys": nrm(ks[18], (DEPTH, PEER_HEADS, 2, N_KEYS, PEER_SUBDIM), PEER_SUBDIM ** -0.5),
        "peer_u": nrm(ks[19], (DEPTH, N_EXPERTS, d), d ** -0.5),
        "peer_v": nrm(ks[20], (DEPTH, N_EXPERTS, d), DN_BETA * PEER_HEADS ** -0.5),
        "ln2_g": 1.0 + nrm(ks[21], (DEPTH, d), 0.02),
        "ln2_b": nrm(ks[22], (DEPTH, d), 0.02),
    }


def reference(x_prompt, x_sample, state_ret, cache_k, cache_v, c, c_ctx, w_ada, b_ada, w_in,
              ret_decay_logit, ret_gn_g, q_norm_g, k_norm_g, w_o, ln1_g, ln1_b,
              peer_w_q, peer_sub_keys, peer_u, peer_v, ln2_g, ln2_b):
    y_p = x_prompt
    y_s = x_sample
    cond_ctx = c_ctx[None, :]
    new_ret, new_k, new_v = [], [], []
    for i in range(DEPTH):
        p = (w_ada[i], b_ada[i], w_in[i], ret_decay_logit[i], ret_gn_g[i], q_norm_g[i], k_norm_g[i], w_o[i],
             ln1_g[i], ln1_b[i], peer_w_q[i], peer_sub_keys[i], peer_u[i], peer_v[i], ln2_g[i], ln2_b[i])
        y_p, (s_ret, k_c, v_c) = _layer(y_p, cond_ctx, p, None)
        new_ret.append(s_ret)
        new_k.append(k_c)
        new_v.append(v_c)
        ctx = (state_ret[:, i, 0], state_ret[:, i, 1], cache_k[:, i], cache_v[:, i])
        y_s, _ = _layer(y_s, c, p, ctx)
    new_state_ret = jnp.stack(new_ret, axis=1)
    new_cache_k = jnp.stack(new_k, axis=1)
    new_cache_v = jnp.stack(new_v, axis=1)
    return (y_p, y_s, new_state_ret, new_cache_k, new_cache_v)
```

```cpp
#include <hip/hip_runtime.h>
#include <hip/hip_cooperative_groups.h>
#include <cstdio>
#include <cstdint>
namespace cg = cooperative_groups;

#define LAS __attribute__((address_space(3)))
typedef unsigned short bf16_t;
typedef short bf16x8 __attribute__((ext_vector_type(8)));
typedef short s16x4 __attribute__((ext_vector_type(4)));
typedef float f32x4 __attribute__((ext_vector_type(4)));
typedef float f32x2 __attribute__((ext_vector_type(2)));
typedef float f32x16 __attribute__((ext_vector_type(16)));
typedef unsigned u32x4 __attribute__((ext_vector_type(4)));
typedef unsigned u32x2 __attribute__((ext_vector_type(2)));
typedef unsigned u32x6 __attribute__((ext_vector_type(6)));
typedef float f32x32 __attribute__((ext_vector_type(32)));

constexpr int DM = 2048;
constexpr int TP = 4096;
constexpr int TS = 8192;
constexpr int TT = TP + TS;
constexpr int NCOL = 5632;
constexpr int C_QR = 0, C_KR = 1024, C_VR = 2048, C_GR = 3072, C_QA = 4096, C_KA = 5120, C_VA = 5376;
constexpr int SKV_L = 4352;
constexpr float EPS = 1e-5f;
constexpr float DN_ALPHA = 1.189207115002721f;
constexpr int NTHREADS = 512;
constexpr int LDS_BYTES = 155648;

constexpr size_t O_Y = 0;
constexpr size_t O_STATE = (size_t)TT * DM;
constexpr size_t O_CK = O_STATE + 16ull * 2 * 8 * 16384;
constexpr size_t O_CV = O_CK + 16ull * 256 * 2 * 128;

constexpr size_t WS_MOD  = 0;
constexpr size_t WS_WTIN = 1ull << 20;
constexpr size_t WS_WTO  = WS_WTIN + (size_t)NCOL * DM * 2;
constexpr size_t WS_WTQ  = WS_WTO + (size_t)DM * DM * 2;
constexpr size_t WS_KEYS = WS_WTQ + (size_t)DM * DM * 2;
constexpr size_t WS_KC   = WS_KEYS + 262144ull * 2;
constexpr size_t WS_VC   = WS_KC + 16ull * 2 * 256 * 128 * 2;
constexpr size_t WS_KL   = WS_VC + 16ull * 2 * 256 * 128 * 2;
constexpr size_t WS_VL   = WS_KL + 2ull * 2 * SKV_L * 128 * 2;
constexpr size_t WS_SEL  = WS_VL + 2ull * 2 * SKV_L * 128 * 2;
constexpr size_t WS_H    = WS_SEL + (size_t)TT * 128 * 8;
constexpr size_t WS_A    = WS_H + (size_t)TT * DM * 2;
constexpr size_t WS_B    = WS_A + (size_t)TT * NCOL * 2;
constexpr size_t WS_D    = WS_B + (size_t)TT * DM * 4;
constexpr size_t WS_E    = WS_D + (size_t)TT * DM * 2;
constexpr size_t WS_U8   = WS_E + (size_t)TT * DM * 2;
constexpr size_t WS_END  = WS_U8 + 2ull * 16384 * 2048;
constexpr size_t WS_STATS = 512ull << 10;
static_assert(768ull * 2 * 16384 * 4 <= (size_t)TT * DM * 4, "KVC fits region B");
static_assert(768ull * 2 * 16384 * 2 <= (size_t)TT * DM * 2, "SPREV fits region D");

struct Params {
    const float* x_prompt; const float* x_sample; const float* state_ret; const float* cache_k; const float* cache_v;
    const float* c; const float* c_ctx; const float* w_ada; const float* b_ada; const float* w_in; const float* decay;
    const float* gn_g; const float* qn_g; const float* kn_g; const float* w_o; const float* ln1_g; const float* ln1_b;
    const float* w_q; const float* sub_keys; const float* peer_u; const float* peer_v; const float* ln2_g; const float* ln2_b;
    float* out; unsigned char* ws; int ph_lo, ph_hi; int rep[10]; int pad0, pad1;
};

__device__ __forceinline__ unsigned cvt_pk_bf16(float lo, float hi) { unsigned r; asm volatile("v_cvt_pk_bf16_f32 %0, %1, %2" : "=v"(r) : "v"(lo), "v"(hi)); return r; }
__device__ __forceinline__ bf16_t f2bf(float x) { return (bf16_t)(cvt_pk_bf16(x, 0.f) & 0xffffu); }
__device__ __forceinline__ float bf2f(bf16_t b) { return __uint_as_float(((unsigned)b) << 16); }
__device__ __forceinline__ float bf_lo(unsigned w) { return __uint_as_float(w << 16); }
__device__ __forceinline__ float bf_hi(unsigned w) { return __uint_as_float(w & 0xffff0000u); }
__device__ __forceinline__ float wave_sum(float v) {
#pragma unroll
    for (int o = 32; o; o >>= 1) v += __shfl_xor(v, o);
    return v;
}
__device__ __forceinline__ float log_sigmoid(float x) { return fminf(x, 0.f) - log1pf(__expf(-fabsf(x))); }
__device__ __forceinline__ float silu_f(float x) { return x / (1.f + __expf(-x)); }
__device__ __forceinline__ const float* x_row(const Params& p, int t) { return t < TP ? p.x_prompt + (size_t)t * DM : p.x_sample + (size_t)(t - TP) * DM; }
__device__ __forceinline__ int cond_of(int t) { return t < TP ? 0 : 1 + ((t - TP) >> 12); }

namespace pg8 {
constexpr int BM = 256, BK = 64, HALF = 128, HTB = HALF * BK * 2, STAGE_BYTES = 8 * HTB, NXCD = 8, WGM = 8;
__host__ __device__ __forceinline__ int lds_byte(int r, int c) { const int st = (r >> 4) * 2 + (c >> 5), rr = r & 15, cc = c & 31, ob = rr * 64 + cc * 2; return st * 1024 + (ob ^ (((ob >> 9) & 1) << 5)); }
__host__ __device__ __forceinline__ void stage_rc(int b, int& R, int& C) { const int st = b / 1024, sb = b % 1024, swz = sb ^ (((sb >> 9) & 1) << 5); R = (st >> 1) * 16 + swz / 64; C = (st & 1) * 32 + (swz % 64) / 2; }
__host__ __device__ __forceinline__ int perm32(int rho) { const int n = rho >> 4, i = rho & 15; return 8 * (i >> 2) + 4 * n + (i & 3); }
struct Unit { int pm, pn; };
struct Gemm { const bf16_t* A; const bf16_t* Bt; int M, N, K; };
struct StaticOrder {
    int nM, nN, nwg, G, c;
    __device__ void init(int M, int N, int G_, int c_) { nM = M / BM; nN = N / BM; nwg = nM * nN; G = G_; c = c_; }
    __device__ bool next(int i, Unit& u) const {
        const long L = (long)i * G + c; if (L >= nwg) return false;
        int wgid = (int)L; { const int q = nwg / NXCD, r = nwg % NXCD, xcd = wgid % NXCD, off = wgid / NXCD; wgid = (xcd < r ? xcd * (q + 1) : r * (q + 1) + (xcd - r) * q) + off; }
        const int nig = WGM * nN, gid = wgid / nig, fm = gid * WGM, gsz = (nM - fm) < WGM ? (nM - fm) : WGM;
        u.pm = fm + ((wgid % nig) % gsz); u.pn = (wgid % nig) / gsz; return true;
    }
    __device__ __forceinline__ void a_ready(const Unit&) const {}
    __device__ __forceinline__ void done(const Unit&) const {}
};
struct EpiBf16 {
    static constexpr bool PERM = true;
    bf16_t* O; int ldc;
    __device__ __forceinline__ void operator()(const f32x4 (&acc)[2][2][4][2], const Unit& u, int wr, int wc, int fr, int fq) const {
        const int row0 = u.pm * BM + wr * 64 + fr; const int col0 = u.pn * BM + wc * 32 + 8 * fq;
#pragma unroll
        for (int ai = 0; ai < 2; ++ai)
#pragma unroll
            for (int m = 0; m < 4; ++m) { bf16_t* rowp = O + (size_t)(row0 + ai * HALF + m * 16) * ldc + col0;
#pragma unroll
                for (int bj = 0; bj < 2; ++bj) { const f32x4 v0 = acc[ai][bj][m][0], v1 = acc[ai][bj][m][1];
                    u32x4 w; w.x = cvt_pk_bf16(v0[0], v0[1]); w.y = cvt_pk_bf16(v0[2], v0[3]); w.z = cvt_pk_bf16(v1[0], v1[1]); w.w = cvt_pk_bf16(v1[2], v1[3]);
                    *(u32x4*)(rowp + bj * HALF) = w; } }
    }
};
struct EpiY1 {
    static constexpr bool PERM = true;
    bf16_t* Y; const float* xp; const float* xs; const float* mod;
    __device__ __forceinline__ void operator()(const f32x4 (&acc)[2][2][4][2], const Unit& u, int wr, int wc, int fr, int fq) const {
        const int row0 = u.pm * BM + wr * 64 + fr, col0 = u.pn * BM + wc * 32 + 8 * fq;
        const int cnd = (u.pm * BM) < TP ? 0 : 1 + ((u.pm * BM - TP) >> 12);
        const float* g1 = mod + (size_t)cnd * 12288 + 2 * 2048;
        f32x4 gv[2][2];
#pragma unroll
        for (int bj = 0; bj < 2; ++bj)
#pragma unroll
            for (int n = 0; n < 2; ++n) gv[bj][n] = *(const f32x4*)(g1 + col0 + bj * HALF + n * 4);
#pragma unroll
        for (int ai = 0; ai < 2; ++ai)
#pragma unroll
            for (int m = 0; m < 4; ++m) { const int row = row0 + ai * HALF + m * 16;
                const float* xr = (row < TP ? xp + (size_t)row * DM : xs + (size_t)(row - TP) * DM) + col0;
                bf16_t* yr = Y + (size_t)row * DM + col0;
#pragma unroll
                for (int bj = 0; bj < 2; ++bj) { const f32x4 x0 = __builtin_nontemporal_load((const f32x4*)(xr + bj * HALF)), x1 = __builtin_nontemporal_load((const f32x4*)(xr + bj * HALF + 4));
                    const f32x4 v0 = x0 * DN_ALPHA + gv[bj][0] * acc[ai][bj][m][0], v1 = x1 * DN_ALPHA + gv[bj][1] * acc[ai][bj][m][1];
                    u32x4 w; w.x = cvt_pk_bf16(v0[0], v0[1]); w.y = cvt_pk_bf16(v0[2], v0[3]); w.z = cvt_pk_bf16(v1[0], v1[1]); w.w = cvt_pk_bf16(v1[2], v1[3]);
                    *(u32x4*)(yr + bj * HALF) = w; } }
    }
};

template <class Epi, class Sched>
__device__ __forceinline__ void gemm_phase(LAS unsigned char* lds, const Gemm g, const Sched& S, const Epi& E) {
    const int tid = threadIdx.x, wid = __builtin_amdgcn_readfirstlane(tid >> 6), lane = tid & 63, wr = wid >> 2, wc = wid & 3, fr = lane & 15, fq = lane >> 4;
    const int K = g.K, nt = K / BK;
    unsigned voffA[2], voffB[2];
#pragma unroll
    for (int i = 0; i < 2; ++i) { int R, C; stage_rc(tid * 16 + i * 8192, R, C); const int Rb = Epi::PERM ? ((R & ~31) + perm32(R & 31)) : R;
        voffA[i] = (unsigned)(R * K + C) * 2u; voffB[i] = (unsigned)(Rb * K + C) * 2u; }
    const size_t kstep = (size_t)(BK * 2);
    const size_t hstep = (size_t)HALF * K * 2;
    const size_t tstep = 2 * hstep;
    const unsigned ldsw = (unsigned)wid * 1024u;
    const int aoff = lds_byte(wr * 64 + fr, fq * 8), boff = lds_byte(wc * 32 + fr, fq * 8);
#define PG8_SA(b, h) (((b) * 2 + (h)) * HTB)
#define PG8_SB(b, h) ((4 + (b) * 2 + (h)) * HTB)
#define PG8_STAGE(bufoff, gbase, voff) do { _Pragma("unroll") for (int _i = 0; _i < 2; ++_i) \
        __builtin_amdgcn_global_load_lds((const unsigned*)((const char*)(gbase) + (voff)[_i]), (LAS unsigned*)(lds + (bufoff) + ldsw + _i * 8192), 16, 0, 0); } while (0)
#define PG8_LDA(dst, b, h) do { _Pragma("unroll") for (int m = 0; m < 4; ++m) _Pragma("unroll") for (int k = 0; k < 2; ++k) dst[m][k] = *(const LAS bf16x8*)(lds + PG8_SA(b, h) + aoff + m * 2048 + k * 1024); } while (0)
#define PG8_LDB(dst, b, h) do { _Pragma("unroll") for (int n = 0; n < 2; ++n) _Pragma("unroll") for (int k = 0; k < 2; ++k) dst[n][k] = *(const LAS bf16x8*)(lds + PG8_SB(b, h) + boff + n * 2048 + k * 1024); } while (0)
#define PG8_MMA(ai, bj, At, Bt) do { __builtin_amdgcn_s_setprio(1); _Pragma("unroll") for (int m = 0; m < 4; ++m) _Pragma("unroll") for (int n = 0; n < 2; ++n) _Pragma("unroll") for (int k = 0; k < 2; ++k) \
        acc[ai][bj][m][n] = __builtin_amdgcn_mfma_f32_16x16x32_bf16(Bt[n][k], At[m][k], acc[ai][bj][m][n], 0, 0, 0); __builtin_amdgcn_s_setprio(0); } while (0)
#define PG8_WAIT_V(n) asm volatile("s_waitcnt vmcnt(" #n ")" ::: "memory")
#define PG8_WAIT_L(n) asm volatile("s_waitcnt lgkmcnt(" #n ")" ::: "memory")
#define PG8_BAR __builtin_amdgcn_s_barrier()
#define PG8_SCHED __builtin_amdgcn_sched_barrier(0)
    Unit cur, nxt; int ui = 0;
    if (!S.next(0, cur)) return;
    f32x4 acc[2][2][4][2];
#pragma unroll
    for (int a = 0; a < 2; ++a)
#pragma unroll
        for (int b = 0; b < 2; ++b)
#pragma unroll
            for (int m = 0; m < 4; ++m)
#pragma unroll
                for (int n = 0; n < 2; ++n) acc[a][b][m][n] = (f32x4){0.f, 0.f, 0.f, 0.f};
    bf16x8 At[4][2], B0[2][2], B1[2][2];
    const char* cA = (const char*)g.A + (size_t)cur.pm * tstep; const char* cB = (const char*)g.Bt + (size_t)cur.pn * tstep;
    S.a_ready(cur);
    PG8_STAGE(PG8_SB(0, 0), cB, voffB); PG8_STAGE(PG8_SA(0, 0), cA, voffA); PG8_STAGE(PG8_SB(0, 1), cB + hstep, voffB); PG8_STAGE(PG8_SA(0, 1), cA + hstep, voffA);
    if (wr == 1) PG8_BAR;
    PG8_WAIT_V(4); PG8_BAR;
    PG8_STAGE(PG8_SB(1, 0), cB + kstep, voffB); PG8_STAGE(PG8_SA(1, 0), cA + kstep, voffA); PG8_STAGE(PG8_SB(1, 1), cB + hstep + kstep, voffB);
    PG8_WAIT_V(6); PG8_BAR;
    for (;;) {
        const bool has_next = S.next(ui + 1, nxt);
        const char* nA = has_next ? (const char*)g.A + (size_t)nxt.pm * tstep : cA; const char* nB = has_next ? (const char*)g.Bt + (size_t)nxt.pn * tstep : cB;
        for (int t = 0; t < nt; t += 2) {
            const bool last = (t == nt - 2);
            const char* a1 = cA + (size_t)(t + 1) * kstep;
            const char* a2 = last ? nA : cA + (size_t)(t + 2) * kstep; const char* b2 = last ? nB : cB + (size_t)(t + 2) * kstep;
            const char* a3 = a2 + kstep; const char* b3 = b2 + kstep;
            if (last && has_next) S.a_ready(nxt);
            PG8_LDB(B0, 0, 0); PG8_SCHED; PG8_LDA(At, 0, 0); PG8_STAGE(PG8_SA(1, 1), a1 + hstep, voffA);
            PG8_WAIT_L(8); PG8_BAR; PG8_WAIT_L(0); PG8_MMA(0, 0, At, B0); PG8_BAR; PG8_SCHED;
            PG8_LDB(B1, 0, 1); PG8_STAGE(PG8_SB(0, 0), b2, voffB);
            PG8_BAR; PG8_WAIT_L(0); PG8_MMA(0, 1, At, B1); PG8_BAR;
            PG8_LDA(At, 0, 1); PG8_STAGE(PG8_SA(0, 0), a2, voffA);
            PG8_BAR; PG8_WAIT_L(0); PG8_MMA(1, 0, At, B0); PG8_BAR; PG8_SCHED;
            PG8_STAGE(PG8_SB(0, 1), b2 + hstep, voffB);
            PG8_WAIT_V(6); PG8_BAR; PG8_MMA(1, 1, At, B1); PG8_BAR;
            PG8_LDB(B0, 1, 0); PG8_SCHED; PG8_LDA(At, 1, 0); PG8_STAGE(PG8_SA(0, 1), a2 + hstep, voffA);
            PG8_WAIT_L(8); PG8_BAR; PG8_WAIT_L(0); PG8_MMA(0, 0, At, B0); PG8_BAR; PG8_SCHED;
            PG8_LDB(B1, 1, 1); PG8_STAGE(PG8_SB(1, 0), b3, voffB);
            PG8_BAR; PG8_WAIT_L(0); PG8_MMA(0, 1, At, B1); PG8_BAR;
            PG8_LDA(At, 1, 1); PG8_STAGE(PG8_SA(1, 0), a3, voffA);
            PG8_BAR; PG8_WAIT_L(0); PG8_MMA(1, 0, At, B0); PG8_BAR; PG8_SCHED;
            PG8_STAGE(PG8_SB(1, 1), b3 + hstep, voffB);
            PG8_WAIT_V(6); PG8_BAR; PG8_MMA(1, 1, At, B1); PG8_BAR;
        }
        E(acc, cur, wr, wc, fr, fq); S.done(cur);
        if (!has_next) break;
#pragma unroll
        for (int a = 0; a < 2; ++a)
#pragma unroll
            for (int b = 0; b < 2; ++b)
#pragma unroll
                for (int m = 0; m < 4; ++m)
#pragma unroll
                    for (int n = 0; n < 2; ++n) acc[a][b][m][n] = (f32x4){0.f, 0.f, 0.f, 0.f};
        cur = nxt; cA = nA; cB = nB; ++ui;
    }
    PG8_WAIT_V(0);
    if (wr == 0) PG8_BAR;
    PG8_BAR;
#undef PG8_SA
#undef PG8_SB
#undef PG8_STAGE
#undef PG8_LDA
#undef PG8_LDB
#undef PG8_MMA
#undef PG8_WAIT_V
#undef PG8_WAIT_L
#undef PG8_BAR
#undef PG8_SCHED
}
}

namespace att {
constexpr int D = 128, NW = 8, QBLK = 32, KVBLK = 64;
constexpr float SCALE = 0.088388347648318440f;
constexpr float THR = 8.f;
constexpr size_t SHM_V = KVBLK * D * 2, SHM_K = KVBLK * D * 2, SHM_ATTN = 2 * SHM_V + 2 * SHM_K + NW * 64 * 4;
#define KSWZ(row, colB) ((row) * 256 + ((colB) ^ (((row) & 7) << 4)))
#define SBAR() __builtin_amdgcn_sched_barrier(0)
__device__ __forceinline__ int crow(int r, int hi) { return (r & 3) + 8 * (r >> 2) + 4 * hi; }
__device__ __forceinline__ void partialSM(f32x16& p0, f32x16& p1, float& m_reg, float& mn, float& alpha) {
  constexpr float C = SCALE * 1.4426950408889634f;
  float pmax = p0[0];
#pragma unroll
  for (int r = 1; r < 16; ++r) pmax = fmaxf(pmax, p0[r]);
#pragma unroll
  for (int r = 0; r < 16; ++r) pmax = fmaxf(pmax, p1[r]);
  { auto rr = __builtin_amdgcn_permlane32_swap(__float_as_uint(pmax), __float_as_uint(pmax), false, false);
    pmax = fmaxf(__uint_as_float(rr[0]), __uint_as_float(rr[1])); }
  if (__builtin_expect(__all(pmax - m_reg <= THR / SCALE), 1)) { mn = m_reg; alpha = 1.f; }
  else { mn = fmaxf(m_reg, pmax); alpha = __builtin_amdgcn_exp2f((m_reg - mn) * C); m_reg = mn; }
  float mnC = -mn * C;
#pragma unroll
  for (int r = 0; r < 16; ++r) p0[r] = fmaf(p0[r], C, mnC);
#pragma unroll
  for (int r = 0; r < 16; ++r) p1[r] = fmaf(p1[r], C, mnC);
#pragma unroll
  for (int r = 0; r < 16; ++r) p0[r] = __builtin_amdgcn_exp2f(p0[r]);
}
__device__ __forceinline__ void finishSM(f32x16& p0, f32x16& p1, float alpha, float& l_reg, bf16x8& pa0, bf16x8& pa1, bf16x8& pa2, bf16x8& pa3) {
#pragma unroll
  for (int r = 0; r < 16; ++r) p1[r] = __builtin_amdgcn_exp2f(p1[r]);
  float ps = 0;
#pragma unroll
  for (int r = 0; r < 16; ++r) ps += p0[r];
#pragma unroll
  for (int r = 0; r < 16; ++r) ps += p1[r];
  { auto rr = __builtin_amdgcn_permlane32_swap(__float_as_uint(ps), __float_as_uint(ps), false, false);
    ps = __uint_as_float(rr[0]) + __uint_as_float(rr[1]); }
  l_reg = l_reg * alpha + ps;
#define PK4(P, BASE, OUT) do { unsigned a0 = cvt_pk_bf16(P[BASE + 0], P[BASE + 1]), a1 = cvt_pk_bf16(P[BASE + 2], P[BASE + 3]);   \
    unsigned b0 = cvt_pk_bf16(P[BASE + 4], P[BASE + 5]), b1 = cvt_pk_bf16(P[BASE + 6], P[BASE + 7]);                              \
    auto r0 = __builtin_amdgcn_permlane32_swap(a0, b0, false, false); auto r1 = __builtin_amdgcn_permlane32_swap(a1, b1, false, false); \
    u32x4 w = {r0[0], r1[0], r0[1], r1[1]}; OUT = *reinterpret_cast<bf16x8*>(&w); } while (0)
  PK4(p0, 0, pa0); PK4(p0, 8, pa1); PK4(p1, 0, pa2); PK4(p1, 8, pa3);
#undef PK4
}
__device__ __forceinline__ void qkt(f32x16& p0, f32x16& p1, const bf16_t* Ks, const bf16x8* qr, int r32, int hi) {
  p0 = f32x16{}; p1 = f32x16{};
#pragma unroll
  for (int d0 = 0; d0 < 8; ++d0) { int cb = (d0 * 16 + hi * 8) * 2;
    bf16x8 b0 = *reinterpret_cast<const bf16x8*>((const char*)Ks + KSWZ(r32, cb));
    bf16x8 b1 = *reinterpret_cast<const bf16x8*>((const char*)Ks + KSWZ(32 + r32, cb));
    p0 = __builtin_amdgcn_mfma_f32_32x32x16_bf16(b0, qr[d0], p0, 0, 0, 0);
    p1 = __builtin_amdgcn_mfma_f32_32x32x16_bf16(b1, qr[d0], p1, 0, 0, 0); }
}
__device__ __forceinline__ int v_st(int k, int c) { const int kk = (k & ~0xC) | ((k & 4) << 1) | ((k & 8) >> 1); return ((kk >> 3) * 4 + (c >> 5)) * 512 + ((kk & 7) * 32 + (c & 31)) * 2; }
__device__ __forceinline__ int v_rd_base(int lane) { return ((lane & 3) << 3) | (((lane >> 2) & 3) << 6) | (((lane >> 4) & 1) << 5) | (((lane >> 5) & 1) << 8); }
constexpr int v_rd_off(int d0, int ks, int half) { return d0 * 512 + ks * 4096 + half * 2048; }
template <int OFF> __device__ __forceinline__ s16x4 tr_read(int vb) {
  s16x4 r; asm volatile("ds_read_b64_tr_b16 %0, %1 offset:%2" : "=&v"(r) : "v"(vb), "i"(OFF) : "memory"); return r;
}
template <int D0> __device__ __forceinline__ void pv_one(f32x16& od, int vb, bf16x8 pa0, bf16x8 pa1, bf16x8 pa2, bf16x8 pa3) {
  const s16x4 l0 = tr_read<v_rd_off(D0, 0, 0)>(vb), h0 = tr_read<v_rd_off(D0, 0, 1)>(vb), l1 = tr_read<v_rd_off(D0, 1, 0)>(vb), h1 = tr_read<v_rd_off(D0, 1, 1)>(vb);
  const s16x4 l2 = tr_read<v_rd_off(D0, 2, 0)>(vb), h2 = tr_read<v_rd_off(D0, 2, 1)>(vb), l3 = tr_read<v_rd_off(D0, 3, 0)>(vb), h3 = tr_read<v_rd_off(D0, 3, 1)>(vb);
  asm volatile("s_waitcnt lgkmcnt(0)" ::: "memory"); SBAR();
#define PK(L, H) (bf16x8){L[0], L[1], L[2], L[3], H[0], H[1], H[2], H[3]}
  od = __builtin_amdgcn_mfma_f32_32x32x16_bf16(pa0, PK(l0, h0), od, 0, 0, 0);
  od = __builtin_amdgcn_mfma_f32_32x32x16_bf16(pa1, PK(l1, h1), od, 0, 0, 0);
  od = __builtin_amdgcn_mfma_f32_32x32x16_bf16(pa2, PK(l2, h2), od, 0, 0, 0);
  od = __builtin_amdgcn_mfma_f32_32x32x16_bf16(pa3, PK(l3, h3), od, 0, 0, 0);
#undef PK
}
__device__ __forceinline__ void pv_d0(f32x16* o, int vb, bf16x8 pa0, bf16x8 pa1, bf16x8 pa2, bf16x8 pa3) {
  pv_one<0>(o[0], vb, pa0, pa1, pa2, pa3); pv_one<1>(o[1], vb, pa0, pa1, pa2, pa3); pv_one<2>(o[2], vb, pa0, pa1, pa2, pa3); pv_one<3>(o[3], vb, pa0, pa1, pa2, pa3);
}
template <int LDQ, int LDK, int LDO>
__device__ __forceinline__ void attn_dense_body(const bf16_t* __restrict__ Qb, const bf16_t* __restrict__ Kh, const bf16_t* __restrict__ Vh,
                                                bf16_t* __restrict__ Ob, int seq, char* lds) {
  const int tid = threadIdx.x, wid = tid >> 6, lane = tid & 63, r32 = lane & 31, hi = lane >> 5;
  bf16_t* V_lds = (bf16_t*)lds; bf16_t* K_lds = (bf16_t*)(lds + 2 * SHM_V);
  float* ws = (float*)(lds + 2 * SHM_V + 2 * SHM_K) + wid * 64; float* li_l = ws; float* al_l = ws + 32;
  float m_reg = -1e30f, l_reg = 0; f32x16 o[4] = {}; bf16x8 qr[8];
  const bf16_t* Qw = Qb + (long)(wid * QBLK + r32) * LDQ + hi * 8;
#pragma unroll
  for (int d0 = 0; d0 < 8; ++d0) qr[d0] = *reinterpret_cast<const bf16x8*>(Qw + d0 * 16);
  const int sr = tid >> 4, sc = (tid & 15) * 8, vst0 = v_st(sr, sc), vst1 = v_st(32 + sr, sc);
  const int vb0 = (int)(uintptr_t)V_lds + v_rd_base(lane);
  struct { bf16x8 vs0, vs1, ks0, ks1; } sr_[2];
#define SLOAD(i, k0) do { sr_[i].vs0 = *(const bf16x8*)(&Vh[(long)((k0) + sr) * LDK + sc]); sr_[i].vs1 = *(const bf16x8*)(&Vh[(long)((k0) + 32 + sr) * LDK + sc]); \
    sr_[i].ks0 = *(const bf16x8*)(&Kh[(long)((k0) + sr) * LDK + sc]); sr_[i].ks1 = *(const bf16x8*)(&Kh[(long)((k0) + 32 + sr) * LDK + sc]); } while (0)
#define SWRITE(b, i) do { *(bf16x8*)((char*)V_lds + (b) * SHM_V + vst0) = sr_[i].vs0;          \
    *(bf16x8*)((char*)V_lds + (b) * SHM_V + vst1) = sr_[i].vs1; int kc = sc * 2;               \
    *(bf16x8*)((char*)K_lds + (b) * SHM_K + KSWZ(sr, kc)) = sr_[i].ks0;                       \
    *(bf16x8*)((char*)K_lds + (b) * SHM_K + KSWZ(32 + sr, kc)) = sr_[i].ks1; } while (0)
#define SWAIT() asm volatile("s_waitcnt vmcnt(4)" ::: "memory")
#define RESC(a) do { if (__any((a) < 1.f)) { if (hi == 0) al_l[r32] = (a); asm volatile("s_waitcnt lgkmcnt(0)" ::: "memory"); \
    _Pragma("unroll") for (int d = 0; d < 4; ++d) _Pragma("unroll") for (int r = 0; r < 16; ++r) o[d][r] *= al_l[crow(r, hi)]; } } while (0)
  f32x16 pA0, pA1, pB0, pB1; float mnA, mnB, alA, alB; bf16x8 pa0, pa1, pa2, pa3; const int NT = seq / KVBLK;
  constexpr int SE = 0, SO = 1;
  SLOAD(SE, 0); asm volatile("s_waitcnt vmcnt(0)" ::: "memory"); SWRITE(0, SE); __syncthreads();
  qkt(pA0, pA1, K_lds, qr, r32, hi); partialSM(pA0, pA1, m_reg, mnA, alA);
  SLOAD(SO, KVBLK); if (2 < NT) SLOAD(SE, 2 * KVBLK);
  SWAIT(); SWRITE(1, SO); __syncthreads();
  for (int j = 1; j + 1 < NT; j += 2) {
    SBAR(); qkt(pB0, pB1, (bf16_t*)((char*)K_lds + SHM_K), qr, r32, hi);
    finishSM(pA0, pA1, alA, l_reg, pa0, pa1, pa2, pa3); SBAR();
    SLOAD(SO, (j + 2) * KVBLK); SBAR();
    pv_d0(o, vb0, pa0, pa1, pa2, pa3); partialSM(pB0, pB1, m_reg, mnB, alB);
    __syncthreads(); SWAIT(); SWRITE(0, SE);
    RESC(alB); __syncthreads();
    SBAR(); qkt(pA0, pA1, K_lds, qr, r32, hi);
    finishSM(pB0, pB1, alB, l_reg, pa0, pa1, pa2, pa3); SBAR();
    if (j + 3 < NT) SLOAD(SE, (j + 3) * KVBLK); SBAR();
    pv_d0(o, vb0 + (int)SHM_V, pa0, pa1, pa2, pa3); partialSM(pA0, pA1, m_reg, mnA, alA);
    __syncthreads(); SWAIT(); SWRITE(1, SO);
    RESC(alA); __syncthreads();
  }
  SBAR(); qkt(pB0, pB1, (bf16_t*)((char*)K_lds + SHM_K), qr, r32, hi);
  finishSM(pA0, pA1, alA, l_reg, pa0, pa1, pa2, pa3); SBAR();
  pv_d0(o, vb0, pa0, pa1, pa2, pa3); partialSM(pB0, pB1, m_reg, mnB, alB);
  __syncthreads(); RESC(alB);
  finishSM(pB0, pB1, alB, l_reg, pa0, pa1, pa2, pa3); SBAR();
  pv_d0(o, vb0 + (int)SHM_V, pa0, pa1, pa2, pa3);
  if (hi == 0) li_l[r32] = l_reg; asm volatile("s_waitcnt lgkmcnt(0)" ::: "memory");
  float rli[16];
#pragma unroll
  for (int r = 0; r < 16; ++r) rli[r] = __builtin_amdgcn_rcpf(li_l[crow(r, hi)]);
  bf16_t* Ow = Ob + (long)(wid * QBLK) * LDO;
#pragma unroll
  for (int r = 0; r < 16; ++r) { int orow = crow(r, hi);
#pragma unroll
    for (int d0 = 0; d0 < 4; ++d0) Ow[(long)orow * LDO + d0 * 32 + r32] = f2bf(o[d0][r] * rli[r]); }
#undef SLOAD
#undef SWRITE
#undef SWAIT
#undef RESC
}
}

__device__ __forceinline__ void transpose_tile(const float* __restrict__ W, bf16_t* __restrict__ Wt, int K, int N, int tk, int tn, float* tile, bool is_win) {
    const int tid = threadIdx.x;
    float4 v[8];
#pragma unroll
    for (int i = 0; i < 8; ++i) { const f32x4 t4 = __builtin_nontemporal_load((const f32x4*)(W + (size_t)(tk * 64 + (tid >> 6) + 8 * i) * N + tn * 256 + (tid & 63) * 4)); v[i] = (float4){t4[0], t4[1], t4[2], t4[3]}; }
#pragma unroll
    for (int i = 0; i < 8; ++i) { float* tp = tile + ((tid >> 6) + 8 * i) * 257 + (tid & 63) * 4; tp[0] = v[i].x; tp[1] = v[i].y; tp[2] = v[i].z; tp[3] = v[i].w; }
    __syncthreads();
    const int n = tid >> 1, k0 = (tid & 1) * 32; const int col = tn * 256 + n;
    const float s = (is_win && col >= C_KR && col < C_VR) ? 0.08838834764831845f : 1.f;
#pragma unroll
    for (int q = 0; q < 4; ++q) { float f[8];
#pragma unroll
        for (int j = 0; j < 8; ++j) f[j] = tile[(k0 + q * 8 + j) * 257 + n] * s;
        u32x4 w; w.x = cvt_pk_bf16(f[0], f[1]); w.y = cvt_pk_bf16(f[2], f[3]); w.z = cvt_pk_bf16(f[4], f[5]); w.w = cvt_pk_bf16(f[6], f[7]);
        *(u32x4*)(Wt + (size_t)col * K + tk * 64 + k0 + q * 8) = w; }
    __syncthreads();
}
__device__ __forceinline__ void cvt_stream(const float* __restrict__ src, bf16_t* __restrict__ dst, size_t n8, size_t gtid, size_t gthreads) {
    for (size_t i = gtid; i < n8; i += gthreads) {
        const float4 a = *(const float4*)(src + i * 8), b = *(const float4*)(src + i * 8 + 4);
        u32x4 w; w.x = cvt_pk_bf16(a.x, a.y); w.y = cvt_pk_bf16(a.z, a.w); w.z = cvt_pk_bf16(b.x, b.y); w.w = cvt_pk_bf16(b.z, b.w);
        *(u32x4*)(dst + i * 8) = w;
    }
}
__device__ __forceinline__ void phase_prep(const Params& p, unsigned char* smem) {
    const int tid = threadIdx.x, G = gridDim.x, bx = blockIdx.x;
    float* tile = (float*)smem;
    bf16_t* wtin = (bf16_t*)(p.ws + WS_WTIN); bf16_t* wto = (bf16_t*)(p.ws + WS_WTO); bf16_t* wtq = (bf16_t*)(p.ws + WS_WTQ);
    constexpr int T_IN = 32 * 22, T_O = 32 * 8;
    for (int t = bx; t < T_IN + 2 * T_O; t += G) {
        if (t < T_IN) transpose_tile(p.w_in, wtin, DM, NCOL, t / 22, t % 22, tile, true);
        else if (t < T_IN + T_O) { const int u = t - T_IN; transpose_tile(p.w_o, wto, DM, DM, u >> 3, u & 7, tile, false); }
        else { const int u = t - T_IN - T_O; transpose_tile(p.w_q, wtq, DM, DM, u >> 3, u & 7, tile, false); }
    }
    cvt_stream(p.sub_keys, (bf16_t*)(p.ws + WS_KEYS), 262144 / 8, (size_t)bx * NTHREADS + tid, (size_t)G * NTHREADS);
    float* mod = (float*)(p.ws + WS_MOD);
    for (int bi = bx; bi < 192; bi += G) {
        const int ks = bi / 6, cg4 = (bi % 6) * 512 + tid;
        __syncthreads();
        if (tid < 192) { const int c = tid >> 6, kk = tid & 63; const int k = ks * 64 + kk;
            const float v = (c == 0) ? p.c_ctx[k] : p.c[(c - 1) * DM + k]; tile[tid] = silu_f(v); }
        __syncthreads();
        float4 a0 = {0, 0, 0, 0}, a1 = a0, a2 = a0;
        const float* wp = p.w_ada + (size_t)(ks * 64) * 12288 + cg4 * 4;
#pragma unroll 8
        for (int kk = 0; kk < 64; ++kk) { const f32x4 w4 = __builtin_nontemporal_load((const f32x4*)(wp + (size_t)kk * 12288)); const float4 w = {w4[0], w4[1], w4[2], w4[3]};
            const float s0 = tile[kk], s1 = tile[64 + kk], s2 = tile[128 + kk];
            a0.x += s0 * w.x; a0.y += s0 * w.y; a0.z += s0 * w.z; a0.w += s0 * w.w;
            a1.x += s1 * w.x; a1.y += s1 * w.y; a1.z += s1 * w.z; a1.w += s1 * w.w;
            a2.x += s2 * w.x; a2.y += s2 * w.y; a2.z += s2 * w.z; a2.w += s2 * w.w; }
        if (ks == 0) { const float4 b = *(const float4*)(p.b_ada + cg4 * 4);
            a0.x += b.x; a0.y += b.y; a0.z += b.z; a0.w += b.w; a1.x += b.x; a1.y += b.y; a1.z += b.z; a1.w += b.w; a2.x += b.x; a2.y += b.y; a2.z += b.z; a2.w += b.w; }
        float* m0 = mod + cg4 * 4;
        atomicAdd(m0 + 0, a0.x); atomicAdd(m0 + 1, a0.y); atomicAdd(m0 + 2, a0.z); atomicAdd(m0 + 3, a0.w);
        atomicAdd(m0 + 12288 + 0, a1.x); atomicAdd(m0 + 12288 + 1, a1.y); atomicAdd(m0 + 12288 + 2, a1.z); atomicAdd(m0 + 12288 + 3, a1.w);
        atomicAdd(m0 + 24576 + 0, a2.x); atomicAdd(m0 + 24576 + 1, a2.y); atomicAdd(m0 + 24576 + 2, a2.z); atomicAdd(m0 + 24576 + 3, a2.w);
    }
    __syncthreads();
}

__device__ __forceinline__ void phase_h1(const Params& p) {
    const size_t gtid = (size_t)blockIdx.x * NTHREADS + threadIdx.x, gth = (size_t)gridDim.x * NTHREADS;
    const float* mod = (const float*)(p.ws + WS_MOD); bf16_t* H = (bf16_t*)(p.ws + WS_H);
    constexpr size_t NG = (size_t)TT * (DM / 8);
    for (size_t i0 = gtid; i0 < NG; i0 += 4 * gth) {
        float4 xa[4], xb[4];
#pragma unroll
        for (int u = 0; u < 4; ++u) { const size_t i = i0 + u * gth; if (i < NG) { const int t = (int)(i >> 8), c8 = (int)(i & 255) * 8; const float* xr = x_row(p, t) + c8;
            const f32x4 xa4 = __builtin_nontemporal_load((const f32x4*)xr), xb4 = __builtin_nontemporal_load((const f32x4*)(xr + 4)); xa[u] = (float4){xa4[0], xa4[1], xa4[2], xa4[3]}; xb[u] = (float4){xb4[0], xb4[1], xb4[2], xb4[3]}; } }
#pragma unroll
        for (int u = 0; u < 4; ++u) { const size_t i = i0 + u * gth; if (i < NG) { const int t = (int)(i >> 8), c8 = (int)(i & 255) * 8; const float* m = mod + (size_t)cond_of(t) * 12288;
            const float4 sha = *(const float4*)(m + c8), shb = *(const float4*)(m + c8 + 4);
            const float4 sca = *(const float4*)(m + 2048 + c8), scb = *(const float4*)(m + 2048 + c8 + 4);
            u32x4 w;
            w.x = cvt_pk_bf16(xa[u].x * (1.f + sca.x) + sha.x, xa[u].y * (1.f + sca.y) + sha.y);
            w.y = cvt_pk_bf16(xa[u].z * (1.f + sca.z) + sha.z, xa[u].w * (1.f + sca.w) + sha.w);
            w.z = cvt_pk_bf16(xb[u].x * (1.f + scb.x) + shb.x, xb[u].y * (1.f + scb.y) + shb.y);
            w.w = cvt_pk_bf16(xb[u].z * (1.f + scb.z) + shb.z, xb[u].w * (1.f + scb.w) + shb.w);
            *(u32x4*)(H + (size_t)t * DM + c8) = w; } }
    }
}

__device__ __forceinline__ void phase_postproj(const Params& p) {
    const int lane = threadIdx.x & 63; const int gw = blockIdx.x * 8 + (threadIdx.x >> 6), nw = gridDim.x * 8;
    bf16_t* P = (bf16_t*)(p.ws + WS_A);
    bf16_t* KC = (bf16_t*)(p.ws + WS_KC); bf16_t* VC = (bf16_t*)(p.ws + WS_VC); bf16_t* KL = (bf16_t*)(p.ws + WS_KL); bf16_t* VL = (bf16_t*)(p.ws + WS_VL);
    const int grp = lane >> 4, l16 = lane & 15, d0 = l16 * 8, sec = l16 >> 2;
    float invf[8], qg[8], kg[8];
#pragma unroll
    for (int i = 0; i < 8; ++i) { invf[i] = exp2f(-(float)((l16 & 3) * 8 + i) * (13.287712379549449f / 32.f)) * 0.15915494309189535f;
        qg[i] = p.qn_g[d0 + i]; kg[i] = p.kn_g[d0 + i]; }
    for (int t = gw; t < TT; t += nw) {
        const bool lat = t >= TP; const int tl = lat ? t - TP : t;
        bf16_t* rowp = P + (size_t)t * NCOL;
        const u32x4 wa = *(const u32x4*)(rowp + C_QA + grp * 128 + d0), wb = *(const u32x4*)(rowp + C_QA + (grp + 4) * 128 + d0), wc = *(const u32x4*)(rowp + C_KA + grp * 128 + d0);
        float cs[8], sn[8];
        if (lat) { const int l = tl & 4095; const float pos = (float)(sec < 2 ? (l >> 6) : (l & 63));
#pragma unroll
            for (int i = 0; i < 8; ++i) { const float rev = pos * invf[i]; const float fr = rev - floorf(rev); sn[i] = __builtin_amdgcn_sinf(fr); cs[i] = __builtin_amdgcn_cosf(fr); } }
        else {
#pragma unroll
            for (int i = 0; i < 8; ++i) { cs[i] = 1.f; sn[i] = 0.f; } }
        const float sgn = (sec & 1) ? 1.f : -1.f;
        float xa[8], xb[8], xc[8];
#pragma unroll
        for (int e = 0; e < 4; ++e) { xa[2 * e] = bf_lo(wa[e]); xa[2 * e + 1] = bf_hi(wa[e]); xb[2 * e] = bf_lo(wb[e]); xb[2 * e + 1] = bf_hi(wb[e]); xc[2 * e] = bf_lo(wc[e]); xc[2 * e + 1] = bf_hi(wc[e]); }
        float sa = 0.f, sb = 0.f, sc2 = 0.f;
#pragma unroll
        for (int i = 0; i < 8; ++i) { sa += xa[i] * xa[i]; sb += xb[i] * xb[i]; sc2 += xc[i] * xc[i]; }
#pragma unroll
        for (int o = 1; o < 16; o <<= 1) { sa += __shfl_xor(sa, o); sb += __shfl_xor(sb, o); sc2 += __shfl_xor(sc2, o); }
        const float ra = rsqrtf(sa * (1.f / 128.f) + EPS), rb = rsqrtf(sb * (1.f / 128.f) + EPS), rc = rsqrtf(sc2 * (1.f / 128.f) + EPS);
        float oa[8], ob[8], oc[8];
#pragma unroll
        for (int i = 0; i < 8; ++i) { const float ya = xa[i] * ra * qg[i], yb = xb[i] * rb * qg[i], yc = xc[i] * rc * kg[i];
            const float za = __shfl_xor(ya, 4), zb = __shfl_xor(yb, 4), zc = __shfl_xor(yc, 4);
            oa[i] = ya * cs[i] + sgn * za * sn[i]; ob[i] = yb * cs[i] + sgn * zb * sn[i]; oc[i] = yc * cs[i] + sgn * zc * sn[i]; }
        u32x4 pa, pb, pc;
#pragma unroll
        for (int e = 0; e < 4; ++e) { pa[e] = cvt_pk_bf16(oa[2 * e], oa[2 * e + 1]); pb[e] = cvt_pk_bf16(ob[2 * e], ob[2 * e + 1]); pc[e] = cvt_pk_bf16(oc[2 * e], oc[2 * e + 1]); }
        *(u32x4*)(rowp + C_QA + grp * 128 + d0) = pa; *(u32x4*)(rowp + C_QA + (grp + 4) * 128 + d0) = pb;
        const int kvh = grp & 1; const bool isk = grp < 2;
        const u32x4 outw = isk ? pc : wc;
        if (!lat) { const int b = tl >> 8, pos = tl & 255;
            bf16_t* dst = (isk ? KC : VC) + ((size_t)(b * 2 + kvh) * 256 + pos) * 128 + d0; *(u32x4*)dst = outw;
            float* od = p.out + (isk ? O_CK : O_CV) + ((size_t)(b * 256 + pos) * 2 + kvh) * 128 + d0;
            float4 f0, f1;
            if (isk) { f0 = (float4){oc[0], oc[1], oc[2], oc[3]}; f1 = (float4){oc[4], oc[5], oc[6], oc[7]}; }
            else { f0 = (float4){xc[0], xc[1], xc[2], xc[3]}; f1 = (float4){xc[4], xc[5], xc[6], xc[7]}; }
            *(float4*)od = f0; *(float4*)(od + 4) = f1;
        } else { const int b = tl >> 12, l = tl & 4095;
            bf16_t* dst = (isk ? KL : VL) + ((size_t)(b * 2 + kvh) * SKV_L + 256 + l) * 128 + d0; *(u32x4*)dst = outw; }
    }
    for (int task = gw; task < 2 * 256 * 2; task += nw) {
        const int b = task >> 9, pos = (task >> 1) & 255, kvh = task & 1;
        const float* ck = p.cache_k + ((size_t)(b * 256 + pos) * 2 + kvh) * 128; const float* cv = p.cache_v + ((size_t)(b * 256 + pos) * 2 + kvh) * 128;
        bf16_t* kd = KL + ((size_t)(b * 2 + kvh) * SKV_L + pos) * 128; bf16_t* vd = VL + ((size_t)(b * 2 + kvh) * SKV_L + pos) * 128;
        kd[lane] = f2bf(ck[lane]); kd[lane + 64] = f2bf(ck[lane + 64]); vd[lane] = f2bf(cv[lane]); vd[lane + 64] = f2bf(cv[lane + 64]);
    }
}

struct RetItem { int tok0, h, seqk; };
__device__ __forceinline__ void ret_item(int it, int& tok0, int& h) {
    if (it < 256) { const int s = it >> 4; h = (it >> 1) & 7; tok0 = s * 256 + (it & 1) * 128; }
    else { const int u = it - 256; const int s = u >> 8; h = (u >> 5) & 7; tok0 = TP + s * 4096 + (u & 31) * 128; }
}
constexpr int RS = 136;

__device__ __forceinline__ void phase_chunk_kv(const Params& p, unsigned char* smem) {
    const int tid = threadIdx.x, lane = tid & 63, wid = tid >> 6, fr = lane & 15, fq = lane >> 4;
    const bf16_t* P = (const bf16_t*)(p.ws + WS_A); bf16_t* KVC = (bf16_t*)(p.ws + WS_B);
    bf16_t* KT = (bf16_t*)smem; bf16_t* VFT = KT + 128 * RS; bf16_t* VBT = VFT + 128 * RS;
    for (int it = blockIdx.x; it < 768; it += gridDim.x) {
        int tok0, h; ret_item(it, tok0, h);
        const float lgf = log_sigmoid(p.decay[h]), lgb = log_sigmoid(p.decay[8 + h]);
        { const int j = tid & 127, dq = tid >> 7;
          const float zf = __expf(lgf * (float)(127 - j)), zb = __expf(lgb * (float)j);
          const bf16_t* kp = P + (size_t)(tok0 + j) * NCOL + C_KR + h * 128 + dq * 32; const bf16_t* vp = P + (size_t)(tok0 + j) * NCOL + C_VR + h * 128 + dq * 32;
          u32x4 kwv[4], vwv[4];
#pragma unroll
          for (int q = 0; q < 4; ++q) { kwv[q] = *(const u32x4*)(kp + q * 8); vwv[q] = *(const u32x4*)(vp + q * 8); }
          __syncthreads();
#pragma unroll
          for (int q = 0; q < 4; ++q) { const u32x4 kw = kwv[q]; const u32x4 vw = vwv[q];
              bf16_t* kt = KT + (dq * 32 + q * 8) * RS + j; bf16_t* vf = VFT + (dq * 32 + q * 8) * RS + j; bf16_t* vb = VBT + (dq * 32 + q * 8) * RS + j;
#pragma unroll
              for (int e = 0; e < 4; ++e) {
                  kt[(2 * e) * RS] = (bf16_t)(kw[e] & 0xffffu); kt[(2 * e + 1) * RS] = (bf16_t)(kw[e] >> 16);
                  const float v0 = bf_lo(vw[e]), v1 = bf_hi(vw[e]);
                  vf[(2 * e) * RS] = f2bf(v0 * zf); vf[(2 * e + 1) * RS] = f2bf(v1 * zf);
                  vb[(2 * e) * RS] = f2bf(v0 * zb); vb[(2 * e + 1) * RS] = f2bf(v1 * zb); } } }
        __syncthreads();
        const int dir = wid >> 2, n0 = (wid & 3) * 32; const bf16_t* VT = dir ? VBT : VFT;
        f32x4 acc[8][2];
#pragma unroll
        for (int m = 0; m < 8; ++m) { acc[m][0] = (f32x4){0, 0, 0, 0}; acc[m][1] = (f32x4){0, 0, 0, 0}; }
#pragma unroll 1
        for (int ks = 0; ks < 4; ++ks) {
            const bf16x8 b0 = *(const bf16x8*)(VT + (n0 + fr) * RS + ks * 32 + fq * 8), b1 = *(const bf16x8*)(VT + (n0 + 16 + fr) * RS + ks * 32 + fq * 8);
            const bf16_t* ap = KT + fr * RS + ks * 32 + fq * 8;
#pragma unroll
            for (int m = 0; m < 8; ++m) { const bf16x8 a = *(const bf16x8*)(ap + m * 16 * RS);
                acc[m][0] = __builtin_amdgcn_mfma_f32_16x16x32_bf16(a, b0, acc[m][0], 0, 0, 0);
                acc[m][1] = __builtin_amdgcn_mfma_f32_16x16x32_bf16(a, b1, acc[m][1], 0, 0, 0); } }
        bf16_t* dst = KVC + ((size_t)it * 2 + dir) * 16384;
#pragma unroll
        for (int m = 0; m < 8; ++m)
#pragma unroll
            for (int n = 0; n < 2; ++n)
#pragma unroll
                for (int r = 0; r < 4; ++r) dst[(m * 16 + fq * 4 + r) * 128 + n0 + n * 16 + fr] = f2bf(acc[m][n][r]);
    }
    __syncthreads();
}

__device__ __forceinline__ void phase_scan(const Params& p) {
    const int gtid = blockIdx.x * NTHREADS + threadIdx.x, gth = gridDim.x * NTHREADS;
    const bf16_t* KVC = (const bf16_t*)(p.ws + WS_B); bf16_t* SP = (bf16_t*)(p.ws + WS_D);
    for (int u = gtid; u < 32 * 4096; u += gth) {
        const int sq = u >> 12, e4 = (u & 4095) * 4; const int b = sq >> 4, h = (sq >> 1) & 7, dir = sq & 1;
        const float g128 = __expf(128.f * log_sigmoid(p.decay[dir * 8 + h]));
        float4 S = *(const float4*)(p.state_ret + ((size_t)(b * 2 + dir) * 8 + h) * 16384 + e4);
        const int it0 = 256 + (b * 8 + h) * 32;
#pragma unroll 8
        for (int st = 0; st < 32; ++st) { const int c = dir ? 31 - st : st; const size_t o = ((size_t)(it0 + c) * 2 + dir) * 16384 + e4;
            const u32x2 kvw = *(const u32x2*)(KVC + o); const float4 kv = {bf_lo(kvw.x), bf_hi(kvw.x), bf_lo(kvw.y), bf_hi(kvw.y)};
            u32x2 w; w.x = cvt_pk_bf16(S.x, S.y); w.y = cvt_pk_bf16(S.z, S.w); *(u32x2*)(SP + o) = w;
            S.x = g128 * S.x + kv.x; S.y = g128 * S.y + kv.y; S.z = g128 * S.z + kv.z; S.w = g128 * S.w + kv.w; }
    }
    for (int u = gtid; u < 256 * 4096; u += gth) {
        const int sq = u >> 12, e4 = (u & 4095) * 4; const int s = sq >> 4, h = (sq >> 1) & 7, dir = sq & 1;
        const float g128 = __expf(128.f * log_sigmoid(p.decay[dir * 8 + h]));
        const int it0 = (s * 8 + h) * 2;
        const int cfirst = dir ? 1 : 0, csecond = dir ? 0 : 1;
        const size_t o1 = ((size_t)(it0 + cfirst) * 2 + dir) * 16384 + e4, o2 = ((size_t)(it0 + csecond) * 2 + dir) * 16384 + e4;
        const u32x2 k1w = *(const u32x2*)(KVC + o1), k2w = *(const u32x2*)(KVC + o2);
        const float4 k1 = {bf_lo(k1w.x), bf_hi(k1w.x), bf_lo(k1w.y), bf_hi(k1w.y)}, k2 = {bf_lo(k2w.x), bf_hi(k2w.x), bf_lo(k2w.y), bf_hi(k2w.y)};
        u32x2 z; z.x = 0u; z.y = 0u; *(u32x2*)(SP + o1) = z;
        *(u32x2*)(SP + o2) = k1w;
        float4 f; f.x = g128 * k1.x + k2.x; f.y = g128 * k1.y + k2.y; f.z = g128 * k1.z + k2.z; f.w = g128 * k1.w + k2.w;
        __builtin_nontemporal_store((f32x4){f.x, f.y, f.z, f.w}, (f32x4*)(p.out + O_STATE + ((size_t)(s * 2 + dir) * 8 + h) * 16384 + e4));
    }
}

__device__ __forceinline__ void phase_attention(const Params& p, unsigned char* smem) {
    const bf16_t* P = (const bf16_t*)(p.ws + WS_A); bf16_t* MIX = (bf16_t*)(p.ws + WS_E);
    const bf16_t* KC = (const bf16_t*)(p.ws + WS_KC); const bf16_t* VC = (const bf16_t*)(p.ws + WS_VC);
    const bf16_t* KL = (const bf16_t*)(p.ws + WS_KL); const bf16_t* VL = (const bf16_t*)(p.ws + WS_VL);
    for (int it = blockIdx.x; it < 384; it += gridDim.x) {
        __syncthreads();
        if (it < 256) { const int b = it >> 7, h = (it >> 4) & 7, qb = it & 15; const int tok0 = TP + b * 4096 + qb * 256; const int kvh = h >> 2;
            att::attn_dense_body<NCOL, 128, DM>(P + (size_t)tok0 * NCOL + C_QA + h * 128, KL + (size_t)(b * 2 + kvh) * SKV_L * 128, VL + (size_t)(b * 2 + kvh) * SKV_L * 128,
                                                MIX + (size_t)tok0 * DM + 1024 + h * 128, SKV_L, (char*)smem);
        } else { const int u = it - 256; const int b = u >> 3, h = u & 7; const int tok0 = b * 256; const int kvh = h >> 2;
            att::attn_dense_body<NCOL, 128, DM>(P + (size_t)tok0 * NCOL + C_QA + h * 128, KC + (size_t)(b * 2 + kvh) * 256 * 128, VC + (size_t)(b * 2 + kvh) * 256 * 128,
                                                MIX + (size_t)tok0 * DM + 1024 + h * 128, 256, (char*)smem);
        }
    }
    __syncthreads();
}

__device__ __forceinline__ void phase_ret_out(const Params& p, unsigned char* smem) {
    const int tid = threadIdx.x, lane = tid & 63, wid = tid >> 6, fr = lane & 15, fq = lane >> 4;
    const bf16_t* P = (const bf16_t*)(p.ws + WS_A); const bf16_t* SP = (const bf16_t*)(p.ws + WS_D); bf16_t* MIX = (bf16_t*)(p.ws + WS_E);
    bf16_t* KN = (bf16_t*)smem; bf16_t* VT = KN + 128 * RS; bf16_t* SFT = VT + 128 * RS; bf16_t* SBT = SFT + 128 * RS;
    for (int it = blockIdx.x; it < 768; it += gridDim.x) {
        int tok0, h; ret_item(it, tok0, h);
        const float lgf = log_sigmoid(p.decay[h]), lgb = log_sigmoid(p.decay[8 + h]);
        { u32x4 kq[4];
#pragma unroll
          for (int q = 0; q < 4; ++q) kq[q] = *(const u32x4*)(P + (size_t)(tok0 + (tid >> 4) + 32 * q) * NCOL + C_KR + h * 128 + (tid & 15) * 8);
          const int j = tid & 127, dq = tid >> 7;
          const bf16_t* vp = P + (size_t)(tok0 + j) * NCOL + C_VR + h * 128 + dq * 32;
          const bf16_t* sf = SP + ((size_t)it * 2 + 0) * 16384 + j * 128 + dq * 32; const bf16_t* sb = SP + ((size_t)it * 2 + 1) * 16384 + j * 128 + dq * 32;
          u32x4 vwv[4], fwv[4], bwv[4];
#pragma unroll
          for (int q = 0; q < 4; ++q) { vwv[q] = *(const u32x4*)(vp + q * 8); fwv[q] = *(const u32x4*)(sf + q * 8); bwv[q] = *(const u32x4*)(sb + q * 8); }
          __syncthreads();
#pragma unroll
          for (int q = 0; q < 4; ++q) *(u32x4*)(KN + ((tid >> 4) + 32 * q) * RS + (tid & 15) * 8) = kq[q];
#pragma unroll
          for (int q = 0; q < 4; ++q) { const u32x4 vw = vwv[q], fw = fwv[q], bw = bwv[q];
              bf16_t* vt = VT + (dq * 32 + q * 8) * RS + j; bf16_t* ft = SFT + (dq * 32 + q * 8) * RS + j; bf16_t* bt = SBT + (dq * 32 + q * 8) * RS + j;
#pragma unroll
              for (int e = 0; e < 4; ++e) {
                  vt[(2 * e) * RS] = (bf16_t)(vw[e] & 0xffffu); vt[(2 * e + 1) * RS] = (bf16_t)(vw[e] >> 16);
                  ft[(2 * e) * RS] = (bf16_t)(fw[e] & 0xffffu); ft[(2 * e + 1) * RS] = (bf16_t)(fw[e] >> 16);
                  bt[(2 * e) * RS] = (bf16_t)(bw[e] & 0xffffu); bt[(2 * e + 1) * RS] = (bf16_t)(bw[e] >> 16); } } }
        const int i0 = wid * 16;
        bf16x8 qf[4], qxf[4], qxb[4];
        { const float xf = __expf(lgf * (float)(i0 + fr + 1)), xb = __expf(lgb * (float)(128 - (i0 + fr)));
#pragma unroll
          for (int ks = 0; ks < 4; ++ks) { const u32x4 w = *(const u32x4*)(P + (size_t)(tok0 + i0 + fr) * NCOL + C_QR + h * 128 + ks * 32 + fq * 8);
              qf[ks] = *reinterpret_cast<const bf16x8*>(&w); u32x4 wf, wb;
#pragma unroll
              for (int e = 0; e < 4; ++e) { const float lo = bf_lo(w[e]), hi = bf_hi(w[e]); wf[e] = cvt_pk_bf16(lo * xf, hi * xf); wb[e] = cvt_pk_bf16(lo * xb, hi * xb); }
              qxf[ks] = *reinterpret_cast<bf16x8*>(&wf); qxb[ks] = *reinterpret_cast<bf16x8*>(&wb); } }
        __syncthreads();
        bf16x8 pa[4];
        {
            f32x4 sc[8];
#pragma unroll
            for (int mt = 0; mt < 8; ++mt) { sc[mt] = (f32x4){0, 0, 0, 0};
                const bf16_t* kp = KN + (mt * 16 + fr) * RS + fq * 8;
#pragma unroll
                for (int ks = 0; ks < 4; ++ks) { const bf16x8 a = *(const bf16x8*)(kp + ks * 32);
                    sc[mt] = __builtin_amdgcn_mfma_f32_16x16x32_bf16(a, qf[ks], sc[mt], 0, 0, 0); } }
            const int i = i0 + fr;
#pragma unroll
            for (int mt = 0; mt < 8; ++mt)
#pragma unroll
                for (int r = 0; r < 4; ++r) { const int j = mt * 16 + fq * 4 + r; const int df = i - j;
                    const float m = df > 0 ? __expf(lgf * (float)df) : (df < 0 ? __expf(lgb * (float)(-df)) : 2.f);
                    sc[mt][r] *= m; }
#pragma unroll
            for (int s = 0; s < 4; ++s) { u32x4 w; w.x = cvt_pk_bf16(sc[2 * s][0], sc[2 * s][1]); w.y = cvt_pk_bf16(sc[2 * s][2], sc[2 * s][3]);
                w.z = cvt_pk_bf16(sc[2 * s + 1][0], sc[2 * s + 1][1]); w.w = cvt_pk_bf16(sc[2 * s + 1][2], sc[2 * s + 1][3]); pa[s] = *reinterpret_cast<bf16x8*>(&w); }
        }
        f32x4 oa[8];
#pragma unroll
        for (int nt = 0; nt < 8; ++nt) { oa[nt] = (f32x4){0, 0, 0, 0};
            const int dv = nt * 16 + fr;
#pragma unroll
            for (int s = 0; s < 4; ++s) {
                const u32x2 lo = *(const u32x2*)(VT + dv * RS + s * 32 + fq * 4), hi = *(const u32x2*)(VT + dv * RS + s * 32 + 16 + fq * 4);
                u32x4 bw; bw.x = lo.x; bw.y = lo.y; bw.z = hi.x; bw.w = hi.y;
                oa[nt] = __builtin_amdgcn_mfma_f32_16x16x32_bf16(pa[s], *reinterpret_cast<bf16x8*>(&bw), oa[nt], 0, 0, 0);
                const bf16x8 bf = *(const bf16x8*)(SFT + dv * RS + s * 32 + fq * 8), bb = *(const bf16x8*)(SBT + dv * RS + s * 32 + fq * 8);
                oa[nt] = __builtin_amdgcn_mfma_f32_16x16x32_bf16(qxf[s], bf, oa[nt], 0, 0, 0);
                oa[nt] = __builtin_amdgcn_mfma_f32_16x16x32_bf16(qxb[s], bb, oa[nt], 0, 0, 0); }
            asm volatile("" ::: "memory"); }
#pragma unroll
        for (int r = 0; r < 4; ++r) { const int i = i0 + fq * 4 + r;
            float s1 = 0.f;
#pragma unroll
            for (int nt = 0; nt < 8; ++nt) s1 += oa[nt][r];
            s1 += __shfl_xor(s1, 1); s1 += __shfl_xor(s1, 2); s1 += __shfl_xor(s1, 4); s1 += __shfl_xor(s1, 8);
            const float mu = s1 * (1.f / 128.f); float s2 = 0.f;
#pragma unroll
            for (int nt = 0; nt < 8; ++nt) { const float d = oa[nt][r] - mu; s2 += d * d; }
            s2 += __shfl_xor(s2, 1); s2 += __shfl_xor(s2, 2); s2 += __shfl_xor(s2, 4); s2 += __shfl_xor(s2, 8);
            const float rs = rsqrtf(s2 * (1.f / 128.f) + EPS);
            const bf16_t* gp = P + (size_t)(tok0 + i) * NCOL + C_GR + h * 128; bf16_t* op = MIX + (size_t)(tok0 + i) * DM + h * 128;
#pragma unroll
            for (int nt = 0; nt < 8; ++nt) { const int dv = nt * 16 + fr; const float g = bf2f(gp[dv]);
                op[dv] = f2bf((oa[nt][r] - mu) * rs * p.gn_g[h * 128 + dv] * silu_f(g)); } }
    }
    __syncthreads();
}


constexpr float U_SCALE = 90.f, V_SCALE = 9.5f;
constexpr int ROW4 = 1024;
__device__ __forceinline__ void cvt_fp4_table(const float* __restrict__ src, unsigned char* __restrict__ dst, float scale, size_t gtid, size_t gth) {
    bool swapped;
    { const unsigned cw = __builtin_amdgcn_cvt_scalef32_pk_fp4_f32(0u, 1.0f, -1.0f, 1.0f, 0);
      const f32x2 cr = __builtin_amdgcn_cvt_scalef32_pk_f32_fp4(cw, 1.0f, 0); swapped = cr.x < 0.f; }
    constexpr size_t NU = (size_t)16384 * 64;
    for (size_t i = gtid; i < NU; i += gth) {
        const size_t row = i >> 6; const int l = (int)i & 63;
        const float* sp = src + row * 2048 + l * 4;
        float f[32];
#pragma unroll
        for (int q = 0; q < 8; ++q) { const f32x4 xv = __builtin_nontemporal_load((const f32x4*)(sp + q * 256)); const float4 x = {xv[0], xv[1], xv[2], xv[3]};
            f[q * 4] = fminf(fmaxf(x.x * scale, -6.f), 6.f); f[q * 4 + 1] = fminf(fmaxf(x.y * scale, -6.f), 6.f); f[q * 4 + 2] = fminf(fmaxf(x.z * scale, -6.f), 6.f); f[q * 4 + 3] = fminf(fmaxf(x.w * scale, -6.f), 6.f); }
        u32x4 w;
#pragma unroll
        for (int qd = 0; qd < 4; ++qd) { unsigned ww = 0u;
            if (swapped) {
                ww = __builtin_amdgcn_cvt_scalef32_pk_fp4_f32(ww, f[qd * 8 + 1], f[qd * 8 + 0], 1.0f, 0); ww = __builtin_amdgcn_cvt_scalef32_pk_fp4_f32(ww, f[qd * 8 + 3], f[qd * 8 + 2], 1.0f, 1);
                ww = __builtin_amdgcn_cvt_scalef32_pk_fp4_f32(ww, f[qd * 8 + 5], f[qd * 8 + 4], 1.0f, 2); ww = __builtin_amdgcn_cvt_scalef32_pk_fp4_f32(ww, f[qd * 8 + 7], f[qd * 8 + 6], 1.0f, 3);
            } else {
                ww = __builtin_amdgcn_cvt_scalef32_pk_fp4_f32(ww, f[qd * 8 + 0], f[qd * 8 + 1], 1.0f, 0); ww = __builtin_amdgcn_cvt_scalef32_pk_fp4_f32(ww, f[qd * 8 + 2], f[qd * 8 + 3], 1.0f, 1);
                ww = __builtin_amdgcn_cvt_scalef32_pk_fp4_f32(ww, f[qd * 8 + 4], f[qd * 8 + 5], 1.0f, 2); ww = __builtin_amdgcn_cvt_scalef32_pk_fp4_f32(ww, f[qd * 8 + 6], f[qd * 8 + 7], 1.0f, 3);
            }
            w[qd] = ww; }
        __builtin_nontemporal_store(w, (u32x4*)(dst + row * ROW4 + l * 16));
    }
}

__device__ __forceinline__ void phase_ln1(const Params& p) {
    const int lane = threadIdx.x & 63; const int gw = blockIdx.x * 8 + (threadIdx.x >> 6), nw = gridDim.x * 8;
    const bf16_t* Y = (const bf16_t*)(p.ws + WS_B); bf16_t* H = (bf16_t*)(p.ws + WS_H); const float* mod = (const float*)(p.ws + WS_MOD);
    for (int t = gw; t < TT; t += nw) {
        const bf16_t* yr = Y + (size_t)t * DM; const float* m = mod + (size_t)cond_of(t) * 12288;
        float4 v[8]; float s = 0.f;
#pragma unroll
        for (int c = 0; c < 8; ++c) { const u32x2 yw = *(const u32x2*)(yr + c * 256 + lane * 4); v[c] = (float4){bf_lo(yw.x), bf_hi(yw.x), bf_lo(yw.y), bf_hi(yw.y)}; s += (v[c].x + v[c].y) + (v[c].z + v[c].w); }
        const float mu = wave_sum(s) * (1.f / 2048.f); float q = 0.f;
#pragma unroll
        for (int c = 0; c < 8; ++c) { const float a = v[c].x - mu, b = v[c].y - mu, cc = v[c].z - mu, d = v[c].w - mu; q += (a * a + b * b) + (cc * cc + d * d); }
        const float rs = rsqrtf(wave_sum(q) * (1.f / 2048.f) + EPS);
#pragma unroll
        for (int c = 0; c < 8; ++c) { const int col = c * 256 + lane * 4;
            const float4 g = *(const float4*)(p.ln1_g + col), b = *(const float4*)(p.ln1_b + col);
            const float4 sh = *(const float4*)(m + 3 * 2048 + col), sc = *(const float4*)(m + 4 * 2048 + col);
            float4 x1; x1.x = (v[c].x - mu) * rs * g.x + b.x; x1.y = (v[c].y - mu) * rs * g.y + b.y; x1.z = (v[c].z - mu) * rs * g.z + b.z; x1.w = (v[c].w - mu) * rs * g.w + b.w;
            u32x2 w; w.x = cvt_pk_bf16(x1.x * (1.f + sc.x) + sh.x, x1.y * (1.f + sc.y) + sh.y); w.y = cvt_pk_bf16(x1.z * (1.f + sc.z) + sh.z, x1.w * (1.f + sc.w) + sh.w);
            *(u32x2*)(H + (size_t)t * DM + col) = w; }
        if (lane == 0) *(float2*)(p.ws + WS_STATS + (size_t)t * 8) = (float2){mu, rs};
    }
}

#define XB_TMO      128
#define XB_XCNT(j)  (256  + 64 * (j))
#define XB_XSUB(j)  (1280 + 64 * (j))
#define XB_XGEN(j)  (2304 + 64 * (j))
#define XB_TOP      3328
#define XB_TOPGEN   3392
#define XCD_BAR_WORDS 3456
#define XB_SPIN_CAP (1u << 18)
__device__ __forceinline__ unsigned xb_ld(unsigned* p)              { return __hip_atomic_load(p, __ATOMIC_RELAXED, __HIP_MEMORY_SCOPE_AGENT); }
__device__ __forceinline__ unsigned xb_add(unsigned* p, unsigned v) { return __hip_atomic_fetch_add(p, v, __ATOMIC_RELAXED, __HIP_MEMORY_SCOPE_AGENT); }
__device__ __forceinline__ unsigned xb_xcc_id() { return (unsigned)__builtin_amdgcn_s_getreg((3 << 11) | 20) & 0xFu; }
#define XB_SPIN(cond, bar) do { unsigned _sp = 0; while (cond) { __builtin_amdgcn_s_sleep(1); \
    if ((++_sp & 255u) == 0u) { if (xb_ld(&(bar)[XB_TMO])) break; if (_sp > XB_SPIN_CAP) { atomicAdd(&(bar)[XB_TMO], 1u); break; } } } } while (0)
struct XcdBarrier { unsigned* bar; unsigned x; volatile LAS unsigned* st; };
__device__ __forceinline__ XcdBarrier xcd_barrier_post(unsigned* bar, volatile LAS unsigned* st) {
    XcdBarrier b; b.bar = bar; b.x = xb_xcc_id(); b.st = st;
    if (threadIdx.x == 0) (void)xb_add(&bar[XB_XCNT(b.x)], 1u);
    return b;
}
__device__ __forceinline__ void xcd_barrier_complete(unsigned* bar, unsigned x, unsigned& nloc, unsigned& nx) {
    const unsigned G = gridDim.x * gridDim.y * gridDim.z;
    unsigned sum, cnt, mine, sp = 0u;
    for (;;) {
        sum = 0u; cnt = 0u; mine = 0u;
#pragma unroll
        for (unsigned j = 0; j < 16; ++j) { const unsigned c = xb_ld(&bar[XB_XCNT(j)]); sum += c; cnt += (c > 0u) ? 1u : 0u; mine = (j == x) ? c : mine; }
        if (sum == G) break;
        __builtin_amdgcn_s_sleep(1);
        if ((++sp & 255u) == 0u) { if (xb_ld(&bar[XB_TMO])) break; if (sp > XB_SPIN_CAP) { atomicAdd(&bar[XB_TMO], 1u); break; } }
    }
    nloc = mine > 0u ? mine : 1u; nx = cnt > 0u ? cnt : 1u;
}
__device__ __forceinline__ void xcd_barrier(const XcdBarrier& b) {
    asm volatile("s_waitcnt vmcnt(0)" ::: "memory");
    __syncthreads();
    if (threadIdx.x == 0) {
        unsigned* bar = b.bar;
        __builtin_amdgcn_s_waitcnt(0);
        unsigned nloc = b.st[0], nx = b.st[1];
        if (nloc == 0u) { xcd_barrier_complete(bar, b.x, nloc, nx); b.st[0] = nloc; b.st[1] = nx; }
        const unsigned old = xb_add(&bar[XB_XSUB(b.x)], 1u);
        const unsigned gen = old / nloc;
        if (old + 1u == (gen + 1u) * nloc) {
            __builtin_amdgcn_fence(__ATOMIC_RELEASE, "agent");
            asm volatile("s_waitcnt vmcnt(0)" ::: "memory");
            const unsigned og = xb_add(&bar[XB_TOP], 1u);
            const unsigned tg = og / nx;
            if (og + 1u == (tg + 1u) * nx) xb_add(&bar[XB_TOPGEN], 1u);
            else XB_SPIN(xb_ld(&bar[XB_TOPGEN]) == tg, bar);
            __builtin_amdgcn_fence(__ATOMIC_ACQUIRE, "agent");
            xb_add(&bar[XB_XGEN(b.x)], 1u);
            asm volatile("s_waitcnt vmcnt(0)" ::: "memory");
        } else {
            XB_SPIN(xb_ld(&bar[XB_XGEN(b.x)]) == gen, bar);
            __builtin_amdgcn_fence(__ATOMIC_ACQUIRE, "agent");
            asm volatile("s_waitcnt vmcnt(0)" ::: "memory");
        }
    }
    __syncthreads();
}
constexpr size_t WS_BAR = 3 * 12288 * 4;


__device__ __forceinline__ unsigned fkey(float v) { const unsigned u = __float_as_uint(v); return (u & 0x80000000u) ? ~u : (u | 0x80000000u); }
__device__ __forceinline__ float kval(unsigned k) { return __uint_as_float((k & 0x80000000u) ? (k & 0x7fffffffu) : ~k); }
__device__ __forceinline__ int bitrev4(int x) { return ((x & 1) << 3) | ((x & 2) << 1) | ((x & 4) >> 1) | ((x & 8) >> 3); }
#define TOPK_INSERT(top, key) do { unsigned _k = (key); _Pragma("unroll") for (int _s = 0; _s < 16; ++_s) { const unsigned _hi = top[_s] > _k ? top[_s] : _k; _k = top[_s] > _k ? _k : top[_s]; top[_s] = _hi; } } while (0)

__device__ __forceinline__ void phase_peer(const Params& p, unsigned char* smem, const XcdBarrier& xbar) {
    const int tid = threadIdx.x, lane = tid & 63, wid = tid >> 6, fr = lane & 15, fq = lane >> 4;
    const bf16_t* PQ = (const bf16_t*)(p.ws + WS_D); const bf16_t* KEYS = (const bf16_t*)(p.ws + WS_KEYS);
    const bf16_t* H = (const bf16_t*)(p.ws + WS_H); const bf16_t* X1 = (const bf16_t*)(p.ws + WS_B); const float* mod = (const float*)(p.ws + WS_MOD);
    int* SELI = (int*)(p.ws + WS_SEL); float* SELG = (float*)(p.ws + WS_SEL + (size_t)TT * 128 * 4);
    float* sc = (float*)smem;
    unsigned* tl = (unsigned*)(smem + 256 * 129 * 4);
    const int ntok = TT / gridDim.x;
    const int tbase = blockIdx.x * ntok;
#ifndef PEER_NO_TOPK
    for (int b0 = 0; b0 < ntok; b0 += 16) {
        __syncthreads();
        {
            const int trow = tbase + b0 + fr; const bool tv = (b0 + fr) < ntok;
#pragma unroll
            for (int pp = 0; pp < 2; ++pp) {
                bf16x8 a[4];
#pragma unroll
                for (int ks = 0; ks < 4; ++ks) a[ks] = tv ? *(const bf16x8*)(PQ + (size_t)trow * DM + wid * 256 + pp * 128 + ks * 32 + fq * 8) : (bf16x8){0, 0, 0, 0, 0, 0, 0, 0};
#pragma unroll
                for (int nt = 0; nt < 8; ++nt) { f32x4 acc = {0, 0, 0, 0};
#pragma unroll
                    for (int ks = 0; ks < 4; ++ks) { const bf16x8 bk = *(const bf16x8*)(KEYS + ((size_t)(wid * 2 + pp) * 128 + nt * 16 + fr) * 128 + ks * 32 + fq * 8);
                        acc = __builtin_amdgcn_mfma_f32_16x16x32_bf16(a[ks], bk, acc, 0, 0, 0); }
#pragma unroll
                    for (int r = 0; r < 4; ++r) sc[(((fq * 4 + r) * 8 + wid) * 2 + pp) * 129 + nt * 16 + fr] = acc[r]; }
            }
        }
        __syncthreads();
        if (tid < 256) {
            unsigned top[16];
            const float* lp = sc + tid * 129;
#define CE_DESC(a, b) do { const unsigned _hi = max(a, b), _lo = min(a, b); a = _hi; b = _lo; } while (0)
#define CE_ASC(a, b)  do { const unsigned _hi = max(a, b), _lo = min(a, b); a = _lo; b = _hi; } while (0)
#define SORT16_DESC(v) do { _Pragma("unroll") for (int _k = 2; _k <= 16; _k <<= 1) _Pragma("unroll") for (int _j = _k >> 1; _j > 0; _j >>= 1) _Pragma("unroll") for (int _i = 0; _i < 16; ++_i) { \
                const int _l = _i ^ _j; if (_l > _i) { if ((_i & _k) == 0) CE_DESC(v[_i], v[_l]); else CE_ASC(v[_i], v[_l]); } } } while (0)
#pragma unroll
            for (int i = 0; i < 16; ++i) top[i] = (fkey(lp[i]) & ~127u) | (unsigned)(127 - i);
            SORT16_DESC(top);
#pragma unroll 1
            for (int blk = 1; blk < 8; ++blk) {
                unsigned v[16];
#pragma unroll
                for (int i = 0; i < 16; ++i) v[i] = (fkey(lp[blk * 16 + i]) & ~127u) | (unsigned)(127 - (blk * 16 + i));
                SORT16_DESC(v);
#pragma unroll
                for (int i = 0; i < 16; ++i) top[i] = max(top[i], v[15 - i]);
#pragma unroll
                for (int j = 8; j > 0; j >>= 1)
#pragma unroll
                    for (int i = 0; i < 16; ++i) { const int l = i ^ j; if (l > i) CE_DESC(top[i], top[l]); }
            }
#ifdef SELFCHECK2
            { unsigned ref[16];
#pragma unroll
              for (int s2 = 0; s2 < 16; ++s2) ref[s2] = 0u;
#pragma unroll 4
              for (int n = 0; n < 128; ++n) { const unsigned key = (fkey(lp[n]) & ~127u) | (unsigned)(127 - n); TOPK_INSERT(ref, key); }
              bool badk = false;
#pragma unroll
              for (int s2 = 0; s2 < 16; ++s2) badk |= (ref[s2] != top[s2]);
              if (badk) p.out[O_CV + 1] = __builtin_nanf(""); }
#endif
#undef CE_DESC
#undef CE_ASC
#undef SORT16_DESC
#pragma unroll
            for (int s = 0; s < 16; ++s) tl[tid * 16 + s] = top[s];
        }
        __syncthreads();
        if (tid < 128 && (b0 + (tid >> 3)) < ntok) {
            const unsigned* la = tl + (tid * 2) * 16; const unsigned* lb = la + 16;
            float av[16], bv[16];
#pragma unroll
            for (int s = 0; s < 16; ++s) { av[s] = kval(la[s] & ~127u); bv[s] = kval(lb[s] & ~127u); }
            unsigned top[16];
#define KEY2(i, j) ((fkey(av[i] + bv[j]) & ~255u) | (unsigned)(255 - ((i) * 16 + (j))))
#define CE_DESC(a, b) do { const unsigned _hi = max(a, b), _lo = min(a, b); a = _hi; b = _lo; } while (0)
#define MERGE16(t) do { _Pragma("unroll") for (int _j = 8; _j > 0; _j >>= 1) _Pragma("unroll") for (int _i = 0; _i < 16; ++_i) { const int _l = _i ^ _j; if (_l > _i) CE_DESC(t[_i], t[_l]); } } while (0)
#pragma unroll
            for (int j = 0; j < 16; ++j) top[j] = KEY2(0, j);
#pragma unroll
            for (int r = 1; r < 8; ++r) { const int m = 16 / (r + 1);
#pragma unroll
                for (int q = 0; q < 8; ++q) if (q < m) top[15 - q] = max(top[15 - q], KEY2(r, q));
                MERGE16(top); }
#pragma unroll
            for (int q = 0; q < 8; ++q) top[15 - q] = max(top[15 - q], KEY2(8 + q, 0));
            MERGE16(top);
#ifdef SELFCHECK2
            { unsigned ref[16];
#pragma unroll
              for (int s2 = 0; s2 < 16; ++s2) ref[s2] = 0u;
#pragma unroll
              for (int i = 0; i < 16; ++i)
#pragma unroll
                  for (int j = 0; j < 16; ++j)
                      if ((i + 1) * (j + 1) <= 16) { const unsigned key = KEY2(i, j); TOPK_INSERT(ref, key); }
              bool badk = false;
#pragma unroll
              for (int s2 = 0; s2 < 16; ++s2) badk |= (ref[s2] != top[s2]);
              if (badk) p.out[O_CV + 2] = __builtin_nanf(""); }
#endif
#undef KEY2
#undef CE_DESC
#undef MERGE16
            const float smax = kval(top[0] & ~255u); float e[16]; float es = 0.f;
#pragma unroll
            for (int s = 0; s < 16; ++s) { e[s] = __expf(kval(top[s] & ~255u) - smax); es += e[s]; }
            const float inv = 1.f / es;
            const int t = tbase + b0 + (tid >> 3), hh = tid & 7;
#pragma unroll
            for (int s = 0; s < 16; ++s) { const int pos = 255 - (int)(top[s] & 255u); const int i = pos >> 4, j = pos & 15;
                const int n1 = 127 - (int)(la[i] & 127u), n2 = 127 - (int)(lb[j] & 127u);
                SELI[(size_t)t * 128 + hh * 16 + s] = n1 * 128 + n2; SELG[(size_t)t * 128 + hh * 16 + s] = e[s] * inv; }
        }
    }
#endif
    xcd_barrier(xbar);
#ifndef PEER_NO_GATHER
    const unsigned char* U8 = p.ws + WS_U8; const unsigned char* V8 = U8 + (size_t)16384 * ROW4;
    const int sA = ((lane >> 2) & 15) * 4 + ((lane & 1) << 1) + ((lane >> 1) & 1);
    unsigned* wsl = (unsigned*)smem + wid * 1536;
    u32x4 b0[4], b1[4], b2[4], b3[4];
#define PEER_LN(g, j) ((((g) & 15) << 2) | (((j) & 1) << 1) | (((j) >> 1) & 1))
#define PEER_LOADS(buf, s_) do { const int _s = (s_); const int _g = _s & 31; const unsigned char* _tab = _s < 32 ? U8 : V8; const int _ir = _g < 16 ? idx0 : idx1; \
            _Pragma("unroll") for (int _j = 0; _j < 4; ++_j) { const int _idx = __builtin_amdgcn_readlane(_ir, PEER_LN(_g, _j)); buf[_j] = *(const u32x4*)(_tab + (size_t)_idx * ROW4 + lane * 16); } \
            __builtin_amdgcn_sched_barrier(0); } while (0)
#define PEER_DOTG(buf, g) do { float d[4]; _Pragma("unroll") for (int _j = 0; _j < 4; ++_j) { const u32x4 w = buf[_j]; f32x2 a2 = {0.f, 0.f}; \
            _Pragma("unroll") for (int qd = 0; qd < 4; ++qd) { \
                a2 += __builtin_amdgcn_cvt_scalef32_pk_f32_fp4(w[qd], 1.0f, 0) * (f32x2){hx[qd * 8 + 0], hx[qd * 8 + 1]}; a2 += __builtin_amdgcn_cvt_scalef32_pk_f32_fp4(w[qd], 1.0f, 1) * (f32x2){hx[qd * 8 + 2], hx[qd * 8 + 3]}; \
                a2 += __builtin_amdgcn_cvt_scalef32_pk_f32_fp4(w[qd], 1.0f, 2) * (f32x2){hx[qd * 8 + 4], hx[qd * 8 + 5]}; a2 += __builtin_amdgcn_cvt_scalef32_pk_f32_fp4(w[qd], 1.0f, 3) * (f32x2){hx[qd * 8 + 6], hx[qd * 8 + 7]}; } \
            d[_j] = a2.x + a2.y; } \
          const bool u1 = (lane & 1) != 0; \
          const float s0 = u1 ? d[0] : d[2], k0 = u1 ? d[2] : d[0], s1 = u1 ? d[1] : d[3], k1 = u1 ? d[3] : d[1]; \
          const float e0 = k0 + __shfl_xor(s0, 1), e1 = k1 + __shfl_xor(s1, 1); \
          const bool u2 = (lane & 2) != 0; const float s2 = u2 ? e0 : e1, k2 = u2 ? e1 : e0; \
          float f = k2 + __shfl_xor(s2, 2); f += __shfl_xor(f, 4); f += __shfl_xor(f, 8); f += __shfl_xor(f, 16); f += __shfl_xor(f, 32); \
          if (((lane >> 2) & 15) == ((g) & 15)) { if ((g) < 16) dot0 = f; else dot1 = f; } } while (0)
#define PEER_ACCG(buf, g) do { const float _wr = (g) < 16 ? wt0 : wt1; _Pragma("unroll") for (int _j = 0; _j < 4; ++_j) { \
            const float wk = __uint_as_float(__builtin_amdgcn_readlane(__float_as_uint(_wr), PEER_LN(g, _j))); const f32x2 wk2 = {wk, wk}; const u32x4 w = buf[_j]; \
            _Pragma("unroll") for (int qd = 0; qd < 4; ++qd) { \
                acc[qd * 4 + 0] += wk2 * __builtin_amdgcn_cvt_scalef32_pk_f32_fp4(w[qd], 1.0f, 0); acc[qd * 4 + 1] += wk2 * __builtin_amdgcn_cvt_scalef32_pk_f32_fp4(w[qd], 1.0f, 1); \
                acc[qd * 4 + 2] += wk2 * __builtin_amdgcn_cvt_scalef32_pk_f32_fp4(w[qd], 1.0f, 2); acc[qd * 4 + 3] += wk2 * __builtin_amdgcn_cvt_scalef32_pk_f32_fp4(w[qd], 1.0f, 3); } } } while (0)
    { int k = 0;
      for (int ti = wid; ti < ntok; ti += 8, ++k) {
        const int t = tbase + ti;
        unsigned k0 = ((unsigned)SELI[(size_t)t * 128 + lane] << 7) | (unsigned)lane, k1 = ((unsigned)SELI[(size_t)t * 128 + 64 + lane] << 7) | (unsigned)(64 + lane);
#pragma unroll
        for (int kk = 2; kk <= 128; kk <<= 1) {
#pragma unroll
            for (int j = kk >> 1; j > 0; j >>= 1) {
                if (j == 64) { const unsigned lo = min(k0, k1), hi = max(k0, k1); k0 = lo; k1 = hi; }
                else { const unsigned p0 = __shfl_xor(k0, j), p1 = __shfl_xor(k1, j);
                    const bool lower = (lane & j) == 0;
                    const bool up0 = (kk == 128) ? true : ((lane & kk) == 0);
                    const bool up1 = (kk == 128) ? true : ((kk == 64) ? false : ((lane & kk) == 0));
                    k0 = (lower == up0) ? min(k0, p0) : max(k0, p0);
                    k1 = (lower == up1) ? min(k1, p1) : max(k1, p1); } } }
        const unsigned q0 = __shfl(k0, sA), q1 = __shfl(k1, sA);
        const int idx0 = (int)(q0 >> 7), idx1 = (int)(q1 >> 7);
        const float gt0 = SELG[(size_t)t * 128 + (q0 & 127u)], gt1 = SELG[(size_t)t * 128 + (q1 & 127u)];
        float hx[32];
#pragma unroll
        for (int q = 0; q < 8; ++q) { const u32x2 w = __builtin_nontemporal_load((const u32x2*)(H + (size_t)t * DM + q * 256 + lane * 4));
            hx[q * 4] = bf_lo(w.x); hx[q * 4 + 1] = bf_hi(w.x); hx[q * 4 + 2] = bf_lo(w.y); hx[q * 4 + 3] = bf_hi(w.y); }
        float dot0 = 0.f, dot1 = 0.f;
        PEER_LOADS(b0, 0); PEER_LOADS(b1, 1); PEER_LOADS(b2, 2);
#pragma unroll 1
        for (int sidx = 0; sidx < 32; sidx += 4) {
            if (sidx + 3 < 32) PEER_LOADS(b3, sidx + 3);
            PEER_DOTG(b0, sidx);
            if (sidx + 4 < 32) PEER_LOADS(b0, sidx + 4);
            PEER_DOTG(b1, sidx + 1);
            if (sidx + 5 < 32) PEER_LOADS(b1, sidx + 5);
            PEER_DOTG(b2, sidx + 2);
            if (sidx + 6 < 32) PEER_LOADS(b2, sidx + 6);
            PEER_DOTG(b3, sidx + 3);
        }
        dot0 *= (1.f / U_SCALE); dot1 *= (1.f / U_SCALE);
        const float wt0 = gt0 * 0.5f * dot0 * (1.f + erff(dot0 * 0.70710678118654752f)) * (1.f / V_SCALE);
        const float wt1 = gt1 * 0.5f * dot1 * (1.f + erff(dot1 * 0.70710678118654752f)) * (1.f / V_SCALE);
        wsl[(k * 4 + 0) * 64 + lane] = (unsigned)idx0; wsl[(k * 4 + 1) * 64 + lane] = (unsigned)idx1;
        wsl[(k * 4 + 2) * 64 + lane] = __float_as_uint(wt0); wsl[(k * 4 + 3) * 64 + lane] = __float_as_uint(wt1);
      } }
    { int k = 0;
      for (int ti = wid; ti < ntok; ti += 8, ++k) {
        const int t = tbase + ti;
        const int idx0 = (int)wsl[(k * 4 + 0) * 64 + lane], idx1 = (int)wsl[(k * 4 + 1) * 64 + lane];
        const float wt0 = __uint_as_float(wsl[(k * 4 + 2) * 64 + lane]), wt1 = __uint_as_float(wsl[(k * 4 + 3) * 64 + lane]);
        f32x2 acc[16];
#pragma unroll
        for (int i = 0; i < 16; ++i) acc[i] = (f32x2){0.f, 0.f};
        PEER_LOADS(b0, 32); PEER_LOADS(b1, 33); PEER_LOADS(b2, 34);
#pragma unroll 1
        for (int sidx = 32; sidx < 64; sidx += 4) {
            if (sidx + 3 < 64) PEER_LOADS(b3, sidx + 3);
            PEER_ACCG(b0, sidx - 32);
            if (sidx + 4 < 64) PEER_LOADS(b0, sidx + 4);
            PEER_ACCG(b1, sidx - 31);
            if (sidx + 5 < 64) PEER_LOADS(b1, sidx + 5);
            PEER_ACCG(b2, sidx - 30);
            if (sidx + 6 < 64) PEER_LOADS(b2, sidx + 6);
            PEER_ACCG(b3, sidx - 29);
        }
        const float* m = mod + (size_t)cond_of(t) * 12288 + 5 * 2048;
        const float2 st1 = *(const float2*)(p.ws + WS_STATS + (size_t)t * 8);
        float4 y[8]; float s1 = 0.f, s2 = 0.f;
#pragma unroll
        for (int q = 0; q < 8; ++q) { const int col = q * 256 + lane * 4;
            const float4 g2 = *(const float4*)(m + col); const u32x2 y1w = __builtin_nontemporal_load((const u32x2*)(X1 + (size_t)t * DM + col)); const f32x4 y1v = {bf_lo(y1w.x), bf_hi(y1w.x), bf_lo(y1w.y), bf_hi(y1w.y)}; const float4 l1g = *(const float4*)(p.ln1_g + col), l1b = *(const float4*)(p.ln1_b + col);
            const float4 x1 = {(y1v[0] - st1.x) * st1.y * l1g.x + l1b.x, (y1v[1] - st1.x) * st1.y * l1g.y + l1b.y, (y1v[2] - st1.x) * st1.y * l1g.z + l1b.z, (y1v[3] - st1.x) * st1.y * l1g.w + l1b.w};
            y[q].x = DN_ALPHA * x1.x + g2.x * acc[q * 2].x; y[q].y = DN_ALPHA * x1.y + g2.y * acc[q * 2].y; y[q].z = DN_ALPHA * x1.z + g2.z * acc[q * 2 + 1].x; y[q].w = DN_ALPHA * x1.w + g2.w * acc[q * 2 + 1].y;
            s1 += (y[q].x + y[q].y) + (y[q].z + y[q].w); }
        const float mu = wave_sum(s1) * (1.f / 2048.f);
#pragma unroll
        for (int q = 0; q < 8; ++q) { const float a = y[q].x - mu, b = y[q].y - mu, c = y[q].z - mu, d = y[q].w - mu; s2 += (a * a + b * b) + (c * c + d * d); }
        const float rs = rsqrtf(wave_sum(s2) * (1.f / 2048.f) + EPS);
#pragma unroll
        for (int q = 0; q < 8; ++q) { const int col = q * 256 + lane * 4;
            const float4 lg = *(const float4*)(p.ln2_g + col), lb = *(const float4*)(p.ln2_b + col);
            float4 o; o.x = (y[q].x - mu) * rs * lg.x + lb.x; o.y = (y[q].y - mu) * rs * lg.y + lb.y; o.z = (y[q].z - mu) * rs * lg.z + lb.z; o.w = (y[q].w - mu) * rs * lg.w + lb.w;
            __builtin_nontemporal_store((f32x4){o.x, o.y, o.z, o.w}, (f32x4*)(p.out + O_Y + (size_t)t * DM + col)); }
      } }
#undef PEER_LN
#undef PEER_LOADS
#undef PEER_DOTG
#undef PEER_ACCG
#endif
}


#ifdef SELFCHECK
__device__ __forceinline__ void phase_selfcheck(const Params& p, unsigned char* smem) {
    const int lane = threadIdx.x & 63, wid = threadIdx.x >> 6; const int gw = blockIdx.x * 8 + wid;
    const bf16_t* P = (const bf16_t*)(p.ws + WS_A); const bf16_t* MIX = (const bf16_t*)(p.ws + WS_E);
    const bf16_t* KC = (const bf16_t*)(p.ws + WS_KC); const bf16_t* VC = (const bf16_t*)(p.ws + WS_VC);
    const bf16_t* KL = (const bf16_t*)(p.ws + WS_KL); const bf16_t* VL = (const bf16_t*)(p.ws + WS_VL);
    float* pl = (float*)smem + wid * 4352;
    const int t = (int)(((unsigned)gw * 2654435761u) % (unsigned)TT); const int h = gw & 7; const int kvh = h >> 2;
    const bool lat = t >= TP; const int tl = lat ? t - TP : t;
    const int b = lat ? (tl >> 12) : (tl >> 8); const int S = lat ? SKV_L : 256;
    const bf16_t* Kb = lat ? KL + (size_t)(b * 2 + kvh) * SKV_L * 128 : KC + (size_t)(b * 2 + kvh) * 256 * 128;
    const bf16_t* Vb = lat ? VL + (size_t)(b * 2 + kvh) * SKV_L * 128 : VC + (size_t)(b * 2 + kvh) * 256 * 128;
    bool bad = false;
    { const bf16_t* raw = P + (size_t)t * NCOL + C_KA + kvh * 128;
      float ss = 0.f; for (int d = 0; d < 128; ++d) { const float x = bf2f(raw[d]); ss += x * x; }
      const float r = 1.f / sqrtf(ss / 128.f + EPS);
      for (int d = lane; d < 128; d += 64) {
          const float y = bf2f(raw[d]) * r * p.kn_g[d];
          float o = y;
          if (lat) { const int l = tl & 4095; const int row = l / 64, col = l % 64;
              const int sec = d / 32, fi = d % 32; const float invf = powf(10000.f, -(float)(2 * fi) / 64.f);
              const float ang = (float)(sec < 2 ? row : col) * invf;
              const int dp = (sec & 1) ? d - 32 : d + 32; const float yp = bf2f(raw[dp]) * r * p.kn_g[dp];
              o = (sec & 1) ? y * cosf(ang) + yp * sinf(ang) : y * cosf(ang) - yp * sinf(ang); }
          const float got = bf2f(Kb[(size_t)(lat ? 256 + (tl & 4095) : (tl & 255)) * 128 + d]);
          if (!(fabsf(got - o) <= 0.02f * fabsf(o) + 0.02f)) bad = true; } }
    { const bf16_t* q = P + (size_t)t * NCOL + C_QA + h * 128;
      float mx = -1e30f;
      for (int j = lane; j < S; j += 64) { float sc = 0.f; for (int d = 0; d < 128; ++d) sc += bf2f(q[d]) * bf2f(Kb[(size_t)j * 128 + d]); sc *= 0.08838834764831845f; pl[j] = sc; mx = fmaxf(mx, sc); }
      for (int o = 32; o; o >>= 1) mx = fmaxf(mx, __shfl_xor(mx, o));
      float sum = 0.f;
      for (int j = lane; j < S; j += 64) { const float e = expf(pl[j] - mx); pl[j] = e; sum += e; }
      sum = wave_sum(sum);
      __builtin_amdgcn_s_waitcnt(0);
      for (int d = lane; d < 128; d += 64) { float o = 0.f; for (int j = 0; j < S; ++j) o += pl[j] * bf2f(Vb[(size_t)j * 128 + d]); o /= sum;
          const float got = bf2f(MIX[(size_t)t * DM + 1024 + h * 128 + d]);
          if (!(fabsf(got - o) <= 0.03f * fabsf(o) + 0.004f)) bad = true; } }
    if (bad) p.out[O_CV] = __builtin_nanf("");
}
#endif

__global__ void __launch_bounds__(NTHREADS, 2) fwd_megakernel(Params p) {
    extern __shared__ __attribute__((aligned(16))) unsigned char smem[];
    cg::grid_group grid = cg::this_grid();
    const int lo = p.ph_lo, hi = p.ph_hi;
#ifndef PHM
#define PHM 0x3ff
#endif
#define IN(k) (((PHM >> (k)) & 1) && lo <= (k) && (k) < hi)
    unsigned nbar = 0; unsigned* barw = (unsigned*)(p.ws + WS_BAR);
    { LAS unsigned* stw = (LAS unsigned*)((LAS unsigned char*)smem + (LDS_BYTES - 16)); if (threadIdx.x == 0) { stw[0] = 0u; stw[1] = 0u; } }
    __syncthreads();
    XcdBarrier xbar = xcd_barrier_post((unsigned*)(p.ws + WS_BAR), (volatile LAS unsigned*)((LAS unsigned char*)smem + (LDS_BYTES - 16)));
    if (p.ph_lo < 0) grid.sync();
#define SEAM(k) do { if (IN(k) && IN((k) + 1)) xcd_barrier(xbar); } while (0)
    if (IN(0)) phase_prep(p, smem);
    SEAM(0);
    if (IN(1)) phase_h1(p);
    SEAM(1);
    if (IN(2)) { pg8::Gemm g{(const bf16_t*)(p.ws + WS_H), (const bf16_t*)(p.ws + WS_WTIN), TT, NCOL, DM}; pg8::StaticOrder S; S.init(TT, NCOL, gridDim.x, blockIdx.x);
        pg8::EpiBf16 E{(bf16_t*)(p.ws + WS_A), NCOL}; pg8::gemm_phase(( LAS unsigned char*)smem, g, S, E);
        { const int G = gridDim.x, rem = ((TT / 256) * (NCOL / 256)) % G; const int first = rem, nb = G - rem;
          if ((int)blockIdx.x >= first) { const size_t gt = (size_t)(blockIdx.x - first) * NTHREADS + threadIdx.x, gn = (size_t)nb * NTHREADS;
              cvt_fp4_table(p.peer_u, p.ws + WS_U8, U_SCALE, gt, gn); } } }
    SEAM(2);
    if (IN(3)) { phase_postproj(p); phase_chunk_kv(p, smem); }
    SEAM(3);
    if (IN(4)) { phase_scan(p); phase_attention(p, smem); }
    SEAM(4);
    if (IN(5)) {
#ifdef SELFCHECK
        phase_selfcheck(p, smem); __syncthreads();
#endif
        phase_ret_out(p, smem); }
    SEAM(5);
    if (IN(6)) { pg8::Gemm g{(const bf16_t*)(p.ws + WS_E), (const bf16_t*)(p.ws + WS_WTO), TT, DM, DM}; pg8::StaticOrder S; S.init(TT, DM, gridDim.x, blockIdx.x);
        pg8::EpiY1 E{(bf16_t*)(p.ws + WS_B), p.x_prompt, p.x_sample, (const float*)(p.ws + WS_MOD)}; pg8::gemm_phase((LAS unsigned char*)smem, g, S, E);
        { const int G = gridDim.x, rem = ((TT / 256) * (DM / 256)) % G; const int first = rem, nb = G - rem;
          if ((int)blockIdx.x >= first) { const size_t gt = (size_t)(blockIdx.x - first) * NTHREADS + threadIdx.x, gn = (size_t)nb * NTHREADS;
              cvt_fp4_table(p.peer_v, p.ws + WS_U8 + (size_t)16384 * ROW4, V_SCALE, gt, gn); } } }
    SEAM(6);
    if (IN(7)) phase_ln1(p);
    SEAM(7);
    if (IN(8)) { pg8::Gemm g{(const bf16_t*)(p.ws + WS_H), (const bf16_t*)(p.ws + WS_WTQ), TT, DM, DM}; pg8::StaticOrder S; S.init(TT, DM, gridDim.x, blockIdx.x);
        pg8::EpiBf16 E{(bf16_t*)(p.ws + WS_D), DM}; pg8::gemm_phase((LAS unsigned char*)smem, g, S, E); }
    SEAM(8);
#ifndef REP9
#define REP9 1
#endif
    if (IN(9)) phase_peer(p, smem, xbar);
#undef IN
#undef SEAM
}

#ifndef MK_MULTI
#define MK_MULTI 0
#endif
extern "C" void kernel_launch(void* const* d_in, const int* in_sizes, int n_in, void* d_out, int out_size, void* d_ws, size_t ws_size, hipStream_t stream) {
    static int grid = 0;
    if (grid == 0) {
        if (n_in != 23 || ws_size < WS_END) { fprintf(stderr, "kernel_launch: n_in %d ws %zu (need %zu)\n", n_in, ws_size, (size_t)WS_END); grid = -1; return; }
        if (hipFuncSetAttribute((const void*)fwd_megakernel, hipFuncAttributeMaxDynamicSharedMemorySize, LDS_BYTES) != hipSuccess) { fprintf(stderr, "kernel_launch: hipFuncSetAttribute failed\n"); grid = -1; return; }
        int dev = 0, cus = 0, per_cu = 0;
        hipGetDevice(&dev); hipDeviceGetAttribute(&cus, hipDeviceAttributeMultiprocessorCount, dev);
        hipOccupancyMaxActiveBlocksPerMultiprocessor(&per_cu, (const void*)fwd_megakernel, NTHREADS, LDS_BYTES);
        if (per_cu < 1) { fprintf(stderr, "kernel_launch: occupancy query says %d blocks/CU\n", per_cu); per_cu = 1; }
        grid = cus;
        if (grid > 256) grid = 256;
        if (TT % grid != 0) { fprintf(stderr, "kernel_launch: grid %d does not divide %d tokens\n", grid, TT); grid = -1; return; }
    }
    if (grid < 0) return;
    (void)hipMemsetAsync((char*)d_ws + WS_MOD, 0, 3 * 12288 * 4 + XCD_BAR_WORDS * 4, stream);
    Params p{};
    p.x_prompt = (const float*)d_in[0]; p.x_sample = (const float*)d_in[1]; p.state_ret = (const float*)d_in[2]; p.cache_k = (const float*)d_in[3]; p.cache_v = (const float*)d_in[4];
    p.c = (const float*)d_in[5]; p.c_ctx = (const float*)d_in[6]; p.w_ada = (const float*)d_in[7]; p.b_ada = (const float*)d_in[8]; p.w_in = (const float*)d_in[9]; p.decay = (const float*)d_in[10];
    p.gn_g = (const float*)d_in[11]; p.qn_g = (const float*)d_in[12]; p.kn_g = (const float*)d_in[13]; p.w_o = (const float*)d_in[14]; p.ln1_g = (const float*)d_in[15]; p.ln1_b = (const float*)d_in[16];
    p.w_q = (const float*)d_in[17]; p.sub_keys = (const float*)d_in[18]; p.peer_u = (const float*)d_in[19]; p.peer_v = (const float*)d_in[20]; p.ln2_g = (const float*)d_in[21]; p.ln2_b = (const float*)d_in[22];
    p.out = (float*)d_out; p.ws = (unsigned char*)d_ws;
    for (int i = 0; i < 10; ++i) p.rep[i] = 1;
#ifdef REPX
    p.rep[REPX] = 2;
#endif
#if MK_MULTI
    for (int ph = 0; ph < 10; ++ph) { p.ph_lo = ph; p.ph_hi = ph + 1; hipLaunchKernelGGL(fwd_megakernel, dim3(grid), dim3(NTHREADS), LDS_BYTES, stream, p); }
#else
    p.ph_lo = 0; p.ph_hi = 10;
    void* args[] = {&p};
    hipError_t e = hipLaunchCooperativeKernel((const void*)fwd_megakernel, dim3(grid), dim3(NTHREADS), args, LDS_BYTES, stream);
    if (e != hipSuccess) fprintf(stderr, "kernel_launch: cooperative launch failed: %s (grid %d)\n", hipGetErrorString(e), grid);
#endif
}
```

```cpp
#include <hip/hip_runtime.h>
#include <hip/hip_cooperative_groups.h>
#include <cstdio>
#include <cstdint>
namespace cg = cooperative_groups;

#define LAS __attribute__((address_space(3)))
typedef unsigned short bf16_t;
typedef short bf16x8 __attribute__((ext_vector_type(8)));
typedef short s16x4 __attribute__((ext_vector_type(4)));
typedef float f32x4 __attribute__((ext_vector_type(4)));
typedef float f32x2 __attribute__((ext_vector_type(2)));
typedef float f32x16 __attribute__((ext_vector_type(16)));
typedef unsigned u32x4 __attribute__((ext_vector_type(4)));
typedef unsigned u32x2 __attribute__((ext_vector_type(2)));
typedef unsigned u32x6 __attribute__((ext_vector_type(6)));
typedef float f32x32 __attribute__((ext_vector_type(32)));

constexpr int DM = 2048;
constexpr int TP = 4096;
constexpr int TS = 8192;
constexpr int TT = TP + TS;
constexpr int NCOL = 5632;
constexpr int C_QR = 0, C_KR = 1024, C_VR = 2048, C_GR = 3072, C_QA = 4096, C_KA = 5120, C_VA = 5376;
constexpr int SKV_L = 4352;
constexpr float EPS = 1e-5f;
constexpr float DN_ALPHA = 1.189207115002721f;
constexpr int NTHREADS = 512;
constexpr int LDS_BYTES = 155648;

constexpr size_t O_Y = 0;
constexpr size_t O_STATE = (size_t)TT * DM;
constexpr size_t O_CK = O_STATE + 16ull * 2 * 8 * 16384;
constexpr size_t O_CV = O_CK + 16ull * 256 * 2 * 128;

constexpr size_t WS_MOD  = 0;
constexpr size_t WS_WTIN = 1ull << 20;
constexpr size_t WS_WTO  = WS_WTIN + (size_t)NCOL * DM * 2;
constexpr size_t WS_WTQ  = WS_WTO + (size_t)DM * DM * 2;
constexpr size_t WS_KEYS = WS_WTQ + (size_t)DM * DM * 2;
constexpr size_t WS_KC   = WS_KEYS + 262144ull * 2;
constexpr size_t WS_VC   = WS_KC + 16ull * 2 * 256 * 128 * 2;
constexpr size_t WS_KL   = WS_VC + 16ull * 2 * 256 * 128 * 2;
constexpr size_t WS_VL   = WS_KL + 2ull * 2 * SKV_L * 128 * 2;
constexpr size_t WS_SEL  = WS_VL + 2ull * 2 * SKV_L * 128 * 2;
constexpr size_t WS_H    = WS_SEL + (size_t)TT * 128 * 8;
constexpr size_t WS_A    = WS_H + (size_t)TT * DM * 2;
constexpr size_t WS_B    = WS_A + (size_t)TT * NCOL * 2;
constexpr size_t WS_D    = WS_B + (size_t)TT * DM * 4;
constexpr size_t WS_E    = WS_D + (size_t)TT * DM * 2;
constexpr size_t WS_U8   = WS_E + (size_t)TT * DM * 2;
constexpr size_t WS_END  = WS_U8 + 2ull * 16384 * 2048;
constexpr size_t WS_STATS = 512ull << 10;
static_assert(768ull * 2 * 16384 * 4 <= (size_t)TT * DM * 4, "KVC fits region B");
static_assert(768ull * 2 * 16384 * 2 <= (size_t)TT * DM * 2, "SPREV fits region D");

struct Params {
    const float* x_prompt; const float* x_sample; const float* state_ret; const float* cache_k; const float* cache_v;
    const float* c; const float* c_ctx; const float* w_ada; const float* b_ada; const float* w_in; const float* decay;
    const float* gn_g; const float* qn_g; const float* kn_g; const float* w_o; const float* ln1_g; const float* ln1_b;
    const float* w_q; const float* sub_keys; const float* peer_u; const float* peer_v; const float* ln2_g; const float* ln2_b;
    float* out; unsigned char* ws; int ph_lo, ph_hi; int rep[10]; int pad0, pad1;
};

__device__ __forceinline__ unsigned cvt_pk_bf16(float lo, float hi) { unsigned r; asm volatile("v_cvt_pk_bf16_f32 %0, %1, %2" : "=v"(r) : "v"(lo), "v"(hi)); return r; }
__device__ __forceinline__ bf16_t f2bf(float x) { return (bf16_t)(cvt_pk_bf16(x, 0.f) & 0xffffu); }
__device__ __forceinline__ float bf2f(bf16_t b) { return __uint_as_float(((unsigned)b) << 16); }
__device__ __forceinline__ float bf_lo(unsigned w) { return __uint_as_float(w << 16); }
__device__ __forceinline__ float bf_hi(unsigned w) { return __uint_as_float(w & 0xffff0000u); }
__device__ __forceinline__ float wave_sum(float v) {
#pragma unroll
    for (int o = 32; o; o >>= 1) v += __shfl_xor(v, o);
    return v;
}
__device__ __forceinline__ float log_sigmoid(float x) { return fminf(x, 0.f) - log1pf(__expf(-fabsf(x))); }
__device__ __forceinline__ float silu_f(float x) { return x / (1.f + __expf(-x)); }
__device__ __forceinline__ const float* x_row(const Params& p, int t) { return t < TP ? p.x_prompt + (size_t)t * DM : p.x_sample + (size_t)(t - TP) * DM; }
__device__ __forceinline__ int cond_of(int t) { return t < TP ? 0 : 1 + ((t - TP) >> 12); }

namespace pg8 {
constexpr int BM = 256, BK = 64, HALF = 128, HTB = HALF * BK * 2, STAGE_BYTES = 8 * HTB, NXCD = 8, WGM = 8;
__host__ __device__ __forceinline__ int lds_byte(int r, int c) { const int st = (r >> 4) * 2 + (c >> 5), rr = r & 15, cc = c & 31, ob = rr * 64 + cc * 2; return st * 1024 + (ob ^ (((ob >> 9) & 1) << 5)); }
__host__ __device__ __forceinline__ void stage_rc(int b, int& R, int& C) { const int st = b / 1024, sb = b % 1024, swz = sb ^ (((sb >> 9) & 1) << 5); R = (st >> 1) * 16 + swz / 64; C = (st & 1) * 32 + (swz % 64) / 2; }
__host__ __device__ __forceinline__ int perm32(int rho) { const int n = rho >> 4, i = rho & 15; return 8 * (i >> 2) + 4 * n + (i & 3); }
struct Unit { int pm, pn; };
struct Gemm { const bf16_t* A; const bf16_t* Bt; int M, N, K; };
struct StaticOrder {
    int nM, nN, nwg, G, c;
    __device__ void init(int M, int N, int G_, int c_) { nM = M / BM; nN = N / BM; nwg = nM * nN; G = G_; c = c_; }
    __device__ bool next(int i, Unit& u) const {
        const long L = (long)i * G + c; if (L >= nwg) return false;
        int wgid = (int)L; { const int q = nwg / NXCD, r = nwg % NXCD, xcd = wgid % NXCD, off = wgid / NXCD; wgid = (xcd < r ? xcd * (q + 1) : r * (q + 1) + (xcd - r) * q) + off; }
        const int nig = WGM * nN, gid = wgid / nig, fm = gid * WGM, gsz = (nM - fm) < WGM ? (nM - fm) : WGM;
        u.pm = fm + ((wgid % nig) % gsz); u.pn = (wgid % nig) / gsz; return true;
    }
    __device__ __forceinline__ void a_ready(const Unit&) const {}
    __device__ __forceinline__ void done(const Unit&) const {}
};
struct EpiBf16 {
    static constexpr bool PERM = true;
    bf16_t* O; int ldc;
    __device__ __forceinline__ void operator()(const f32x4 (&acc)[2][2][4][2], const Unit& u, int wr, int wc, int fr, int fq) const {
        const int row0 = u.pm * BM + wr * 64 + fr; const int col0 = u.pn * BM + wc * 32 + 8 * fq;
#pragma unroll
        for (int ai = 0; ai < 2; ++ai)
#pragma unroll
            for (int m = 0; m < 4; ++m) { bf16_t* rowp = O + (size_t)(row0 + ai * HALF + m * 16) * ldc + col0;
#pragma unroll
                for (int bj = 0; bj < 2; ++bj) { const f32x4 v0 = acc[ai][bj][m][0], v1 = acc[ai][bj][m][1];
                    u32x4 w; w.x = cvt_pk_bf16(v0[0], v0[1]); w.y = cvt_pk_bf16(v0[2], v0[3]); w.z = cvt_pk_bf16(v1[0], v1[1]); w.w = cvt_pk_bf16(v1[2], v1[3]);
                    *(u32x4*)(rowp + bj * HALF) = w; } }
    }
};
struct EpiY1 {
    static constexpr bool PERM = true;
    bf16_t* Y; const float* xp; const float* xs; const float* mod;
    __device__ __forceinline__ void operator()(const f32x4 (&acc)[2][2][4][2], const Unit& u, int wr, int wc, int fr, int fq) const {
        const int row0 = u.pm * BM + wr * 64 + fr, col0 = u.pn * BM + wc * 32 + 8 * fq;
        const int cnd = (u.pm * BM) < TP ? 0 : 1 + ((u.pm * BM - TP) >> 12);
        const float* g1 = mod + (size_t)cnd * 12288 + 2 * 2048;
        f32x4 gv[2][2];
#pragma unroll
        for (int bj = 0; bj < 2; ++bj)
#pragma unroll
            for (int n = 0; n < 2; ++n) gv[bj][n] = *(const f32x4*)(g1 + col0 + bj * HALF + n * 4);
#pragma unroll
        for (int ai = 0; ai < 2; ++ai)
#pragma unroll
            for (int m = 0; m < 4; ++m) { const int row = row0 + ai * HALF + m * 16;
                const float* xr = (row < TP ? xp + (size_t)row * DM : xs + (size_t)(row - TP) * DM) + col0;
                bf16_t* yr = Y + (size_t)row * DM + col0;
#pragma unroll
                for (int bj = 0; bj < 2; ++bj) { const f32x4 x0 = __builtin_nontemporal_load((const f32x4*)(xr + bj * HALF)), x1 = __builtin_nontemporal_load((const f32x4*)(xr + bj * HALF + 4));
                    const f32x4 v0 = x0 * DN_ALPHA + gv[bj][0] * acc[ai][bj][m][0], v1 = x1 * DN_ALPHA + gv[bj][1] * acc[ai][bj][m][1];
                    u32x4 w; w.x = cvt_pk_bf16(v0[0], v0[1]); w.y = cvt_pk_bf16(v0[2], v0[3]); w.z = cvt_pk_bf16(v1[0], v1[1]); w.w = cvt_pk_bf16(v1[2], v1[3]);
                    *(u32x4*)(yr + bj * HALF) = w; } }
    }
};

template <class Epi, class Sched>
__device__ __forceinline__ void gemm_phase(LAS unsigned char* lds, const Gemm g, const Sched& S, const Epi& E) {
    const int tid = threadIdx.x, wid = __builtin_amdgcn_readfirstlane(tid >> 6), lane = tid & 63, wr = wid >> 2, wc = wid & 3, fr = lane & 15, fq = lane >> 4;
    const int K = g.K, nt = K / BK;
    unsigned voffA[2], voffB[2];
#pragma unroll
    for (int i = 0; i < 2; ++i) { int R, C; stage_rc(tid * 16 + i * 8192, R, C); const int Rb = Epi::PERM ? ((R & ~31) + perm32(R & 31)) : R;
        voffA[i] = (unsigned)(R * K + C) * 2u; voffB[i] = (unsigned)(Rb * K + C) * 2u; }
    const size_t kstep = (size_t)(BK * 2);
    const size_t hstep = (size_t)HALF * K * 2;
    const size_t tstep = 2 * hstep;
    const unsigned ldsw = (unsigned)wid * 1024u;
    const int aoff = lds_byte(wr * 64 + fr, fq * 8), boff = lds_byte(wc * 32 + fr, fq * 8);
#define PG8_SA(b, h) (((b) * 2 + (h)) * HTB)
#define PG8_SB(b, h) ((4 + (b) * 2 + (h)) * HTB)
#define PG8_STAGE(bufoff, gbase, voff) do { _Pragma("unroll") for (int _i = 0; _i < 2; ++_i) \
        __builtin_amdgcn_global_load_lds((const unsigned*)((const char*)(gbase) + (voff)[_i]), (LAS unsigned*)(lds + (bufoff) + ldsw + _i * 8192), 16, 0, 0); } while (0)
#define PG8_LDA(dst, b, h) do { _Pragma("unroll") for (int m = 0; m < 4; ++m) _Pragma("unroll") for (int k = 0; k < 2; ++k) dst[m][k] = *(const LAS bf16x8*)(lds + PG8_SA(b, h) + aoff + m * 2048 + k * 1024); } while (0)
#define PG8_LDB(dst, b, h) do { _Pragma("unroll") for (int n = 0; n < 2; ++n) _Pragma("unroll") for (int k = 0; k < 2; ++k) dst[n][k] = *(const LAS bf16x8*)(lds + PG8_SB(b, h) + boff + n * 2048 + k * 1024); } while (0)
#define PG8_MMA(ai, bj, At, Bt) do { __builtin_amdgcn_s_setprio(1); _Pragma("unroll") for (int m = 0; m < 4; ++m) _Pragma("unroll") for (int n = 0; n < 2; ++n) _Pragma("unroll") for (int k = 0; k < 2; ++k) \
        acc[ai][bj][m][n] = __builtin_amdgcn_mfma_f32_16x16x32_bf16(Bt[n][k], At[m][k], acc[ai][bj][m][n], 0, 0, 0); __builtin_amdgcn_s_setprio(0); } while (0)
#define PG8_WAIT_V(n) asm volatile("s_waitcnt vmcnt(" #n ")" ::: "memory")
#define PG8_WAIT_L(n) asm volatile("s_waitcnt lgkmcnt(" #n ")" ::: "memory")
#define PG8_BAR __builtin_amdgcn_s_barrier()
#define PG8_SCHED __builtin_amdgcn_sched_barrier(0)
    Unit cur, nxt; int ui = 0;
    if (!S.next(0, cur)) return;
    f32x4 acc[2][2][4][2];
#pragma unroll
    for (int a = 0; a < 2; ++a)
#pragma unroll
        for (int b = 0; b < 2; ++b)
#pragma unroll
            for (int m = 0; m < 4; ++m)
#pragma unroll
                for (int n = 0; n < 2; ++n) acc[a][b][m][n] = (f32x4){0.f, 0.f, 0.f, 0.f};
    bf16x8 At[4][2], B0[2][2], B1[2][2];
    const char* cA = (const char*)g.A + (size_t)cur.pm * tstep; const char* cB = (const char*)g.Bt + (size_t)cur.pn * tstep;
    S.a_ready(cur);
    PG8_STAGE(PG8_SB(0, 0), cB, voffB); PG8_STAGE(PG8_SA(0, 0), cA, voffA); PG8_STAGE(PG8_SB(0, 1), cB + hstep, voffB); PG8_STAGE(PG8_SA(0, 1), cA + hstep, voffA);
    if (wr == 1) PG8_BAR;
    PG8_WAIT_V(4); PG8_BAR;
    PG8_STAGE(PG8_SB(1, 0), cB + kstep, voffB); PG8_STAGE(PG8_SA(1, 0), cA + kstep, voffA); PG8_STAGE(PG8_SB(1, 1), cB + hstep + kstep, voffB);
    PG8_WAIT_V(6); PG8_BAR;
    for (;;) {
        const bool has_next = S.next(ui + 1, nxt);
        const char* nA = has_next ? (const char*)g.A + (size_t)nxt.pm * tstep : cA; const char* nB = has_next ? (const char*)g.Bt + (size_t)nxt.pn * tstep : cB;
        for (int t = 0; t < nt; t += 2) {
            const bool last = (t == nt - 2);
            const char* a1 = cA + (size_t)(t + 1) * kstep;
            const char* a2 = last ? nA : cA + (size_t)(t + 2) * kstep; const char* b2 = last ? nB : cB + (size_t)(t + 2) * kstep;
            const char* a3 = a2 + kstep; const char* b3 = b2 + kstep;
            if (last && has_next) S.a_ready(nxt);
            PG8_LDB(B0, 0, 0); PG8_SCHED; PG8_LDA(At, 0, 0); PG8_STAGE(PG8_SA(1, 1), a1 + hstep, voffA);
            PG8_WAIT_L(8); PG8_BAR; PG8_WAIT_L(0); PG8_MMA(0, 0, At, B0); PG8_BAR; PG8_SCHED;
            PG8_LDB(B1, 0, 1); PG8_STAGE(PG8_SB(0, 0), b2, voffB);
            PG8_BAR; PG8_WAIT_L(0); PG8_MMA(0, 1, At, B1); PG8_BAR;
            PG8_LDA(At, 0, 1); PG8_STAGE(PG8_SA(0, 0), a2, voffA);
            PG8_BAR; PG8_WAIT_L(0); PG8_MMA(1, 0, At, B0); PG8_BAR; PG8_SCHED;
            PG8_STAGE(PG8_SB(0, 1), b2 + hstep, voffB);
            PG8_WAIT_V(6); PG8_BAR; PG8_MMA(1, 1, At, B1); PG8_BAR;
            PG8_LDB(B0, 1, 0); PG8_SCHED; PG8_LDA(At, 1, 0); PG8_STAGE(PG8_SA(0, 1), a2 + hstep, voffA);
            PG8_WAIT_L(8); PG8_BAR; PG8_WAIT_L(0); PG8_MMA(0, 0, At, B0); PG8_BAR; PG8_SCHED;
            PG8_LDB(B1, 1, 1); PG8_STAGE(PG8_SB(1, 0), b3, voffB);
            PG8_BAR; PG8_WAIT_L(0); PG8_MMA(0, 1, At, B1); PG8_BAR;
            PG8_LDA(At, 1, 1); PG8_STAGE(PG8_SA(1, 0), a3, voffA);
            PG8_BAR; PG8_WAIT_L(0); PG8_MMA(1, 0, At, B0); PG8_BAR; PG8_SCHED;
            PG8_STAGE(PG8_SB(1, 1), b3 + hstep, voffB);
            PG8_WAIT_V(6); PG8_BAR; PG8_MMA(1, 1, At, B1); PG8_BAR;
        }
        E(acc, cur, wr, wc, fr, fq); S.done(cur);
        if (!has_next) break;
#pragma unroll
        for (int a = 0; a < 2; ++a)
#pragma unroll
            for (int b = 0; b < 2; ++b)
#pragma unroll
                for (int m = 0; m < 4; ++m)
#pragma unroll
                    for (int n = 0; n < 2; ++n) acc[a][b][m][n] = (f32x4){0.f, 0.f, 0.f, 0.f};
        cur = nxt; cA = nA; cB = nB; ++ui;
    }
    PG8_WAIT_V(0);
    if (wr == 0) PG8_BAR;
    PG8_BAR;
#undef PG8_SA
#undef PG8_SB
#undef PG8_STAGE
#undef PG8_LDA
#undef PG8_LDB
#undef PG8_MMA
#undef PG8_WAIT_V
#undef PG8_WAIT_L
#undef PG8_BAR
#undef PG8_SCHED
}
}

namespace att {
constexpr int D = 128, NW = 8, QBLK = 32, KVBLK = 64;
constexpr float SCALE = 0.088388347648318440f;
constexpr float THR = 8.f;
constexpr size_t SHM_V = KVBLK * D * 2, SHM_K = KVBLK * D * 2, SHM_ATTN = 2 * SHM_V + 2 * SHM_K + NW * 64 * 4;
#define KSWZ(row, colB) ((row) * 256 + ((colB) ^ (((row) & 7) << 4)))
#define SBAR() __builtin_amdgcn_sched_barrier(0)
__device__ __forceinline__ int crow(int r, int hi) { return (r & 3) + 8 * (r >> 2) + 4 * hi; }
__device__ __forceinline__ void partialSM(f32x16& p0, f32x16& p1, float& m_reg, float& mn, float& alpha) {
  constexpr float C = SCALE * 1.4426950408889634f;
  float pmax = p0[0];
#pragma unroll
  for (int r = 1; r < 16; ++r) pmax = fmaxf(pmax, p0[r]);
#pragma unroll
  for (int r = 0; r < 16; ++r) pmax = fmaxf(pmax, p1[r]);
  { auto rr = __builtin_amdgcn_permlane32_swap(__float_as_uint(pmax), __float_as_uint(pmax), false, false);
    pmax = fmaxf(__uint_as_float(rr[0]), __uint_as_float(rr[1])); }
  if (__builtin_expect(__all(pmax - m_reg <= THR / SCALE), 1)) { mn = m_reg; alpha = 1.f; }
  else { mn = fmaxf(m_reg, pmax); alpha = __builtin_amdgcn_exp2f((m_reg - mn) * C); m_reg = mn; }
  float mnC = -mn * C;
#pragma unroll
  for (int r = 0; r < 16; ++r) p0[r] = fmaf(p0[r], C, mnC);
#pragma unroll
  for (int r = 0; r < 16; ++r) p1[r] = fmaf(p1[r], C, mnC);
#pragma unroll
  for (int r = 0; r < 16; ++r) p0[r] = __builtin_amdgcn_exp2f(p0[r]);
}
__device__ __forceinline__ void finishSM(f32x16& p0, f32x16& p1, float alpha, float& l_reg, bf16x8& pa0, bf16x8& pa1, bf16x8& pa2, bf16x8& pa3) {
#pragma unroll
  for (int r = 0; r < 16; ++r) p1[r] = __builtin_amdgcn_exp2f(p1[r]);
  float ps = 0;
#pragma unroll
  for (int r = 0; r < 16; ++r) ps += p0[r];
#pragma unroll
  for (int r = 0; r < 16; ++r) ps += p1[r];
  { auto rr = __builtin_amdgcn_permlane32_swap(__float_as_uint(ps), __float_as_uint(ps), false, false);
    ps = __uint_as_float(rr[0]) + __uint_as_float(rr[1]); }
  l_reg = l_reg * alpha + ps;
#define PK4(P, BASE, OUT) do { unsigned a0 = cvt_pk_bf16(P[BASE + 0], P[BASE + 1]), a1 = cvt_pk_bf16(P[BASE + 2], P[BASE + 3]);   \
    unsigned b0 = cvt_pk_bf16(P[BASE + 4], P[BASE + 5]), b1 = cvt_pk_bf16(P[BASE + 6], P[BASE + 7]);                              \
    auto r0 = __builtin_amdgcn_permlane32_swap(a0, b0, false, false); auto r1 = __builtin_amdgcn_permlane32_swap(a1, b1, false, false); \
    u32x4 w = {r0[0], r1[0], r0[1], r1[1]}; OUT = *reinterpret_cast<bf16x8*>(&w); } while (0)
  PK4(p0, 0, pa0); PK4(p0, 8, pa1); PK4(p1, 0, pa2); PK4(p1, 8, pa3);
#undef PK4
}
__device__ __forceinline__ void qkt(f32x16& p0, f32x16& p1, const bf16_t* Ks, const bf16x8* qr, int r32, int hi) {
  p0 = f32x16{}; p1 = f32x16{};
#pragma unroll
  for (int d0 = 0; d0 < 8; ++d0) { int cb = (d0 * 16 + hi * 8) * 2;
    bf16x8 b0 = *reinterpret_cast<const bf16x8*>((const char*)Ks + KSWZ(r32, cb));
    bf16x8 b1 = *reinterpret_cast<const bf16x8*>((const char*)Ks + KSWZ(32 + r32, cb));
    p0 = __builtin_amdgcn_mfma_f32_32x32x16_bf16(b0, qr[d0], p0, 0, 0, 0);
    p1 = __builtin_amdgcn_mfma_f32_32x32x16_bf16(b1, qr[d0], p1, 0, 0, 0); }
}
__device__ __forceinline__ int v_st(int k, int c) { const int kk = (k & ~0xC) | ((k & 4) << 1) | ((k & 8) >> 1); return ((kk >> 3) * 4 + (c >> 5)) * 512 + ((kk & 7) * 32 + (c & 31)) * 2; }
__device__ __forceinline__ int v_rd_base(int lane) { return ((lane & 3) << 3) | (((lane >> 2) & 3) << 6) | (((lane >> 4) & 1) << 5) | (((lane >> 5) & 1) << 8); }
constexpr int v_rd_off(int d0, int ks, int half) { return d0 * 512 + ks * 4096 + half * 2048; }
template <int OFF> __device__ __forceinline__ s16x4 tr_read(int vb) {
  s16x4 r; asm volatile("ds_read_b64_tr_b16 %0, %1 offset:%2" : "=&v"(r) : "v"(vb), "i"(OFF) : "memory"); return r;
}
template <int D0> __device__ __forceinline__ void pv_one(f32x16& od, int vb, bf16x8 pa0, bf16x8 pa1, bf16x8 pa2, bf16x8 pa3) {
  const s16x4 l0 = tr_read<v_rd_off(D0, 0, 0)>(vb), h0 = tr_read<v_rd_off(D0, 0, 1)>(vb), l1 = tr_read<v_rd_off(D0, 1, 0)>(vb), h1 = tr_read<v_rd_off(D0, 1, 1)>(vb);
  const s16x4 l2 = tr_read<v_rd_off(D0, 2, 0)>(vb), h2 = tr_read<v_rd_off(D0, 2, 1)>(vb), l3 = tr_read<v_rd_off(D0, 3, 0)>(vb), h3 = tr_read<v_rd_off(D0, 3, 1)>(vb);
  asm volatile("s_waitcnt lgkmcnt(0)" ::: "memory"); SBAR();
#define PK(L, H) (bf16x8){L[0], L[1], L[2], L[3], H[0], H[1], H[2], H[3]}
  od = __builtin_amdgcn_mfma_f32_32x32x16_bf16(pa0, PK(l0, h0), od, 0, 0, 0);
  od = __builtin_amdgcn_mfma_f32_32x32x16_bf16(pa1, PK(l1, h1), od, 0, 0, 0);
  od = __builtin_amdgcn_mfma_f32_32x32x16_bf16(pa2, PK(l2, h2), od, 0, 0, 0);
  od = __builtin_amdgcn_mfma_f32_32x32x16_bf16(pa3, PK(l3, h3), od, 0, 0, 0);
#undef PK
}
__device__ __forceinline__ void pv_d0(f32x16* o, int vb, bf16x8 pa0, bf16x8 pa1, bf16x8 pa2, bf16x8 pa3) {
  pv_one<0>(o[0], vb, pa0, pa1, pa2, pa3); pv_one<1>(o[1], vb, pa0, pa1, pa2, pa3); pv_one<2>(o[2], vb, pa0, pa1, pa2, pa3); pv_one<3>(o[3], vb, pa0, pa1, pa2, pa3);
}
template <int LDQ, int LDK, int LDO>
__device__ __forceinline__ void attn_dense_body(const bf16_t* __restrict__ Qb, const bf16_t* __restrict__ Kh, const bf16_t* __restrict__ Vh,
                                                bf16_t* __restrict__ Ob, int seq, char* lds) {
  const int tid = threadIdx.x, wid = tid >> 6, lane = tid & 63, r32 = lane & 31, hi = lane >> 5;
  bf16_t* V_lds = (bf16_t*)lds; bf16_t* K_lds = (bf16_t*)(lds + 2 * SHM_V);
  float* ws = (float*)(lds + 2 * SHM_V + 2 * SHM_K) + wid * 64; float* li_l = ws; float* al_l = ws + 32;
  float m_reg = -1e30f, l_reg = 0; f32x16 o[4] = {}; bf16x8 qr[8];
  const bf16_t* Qw = Qb + (long)(wid * QBLK + r32) * LDQ + hi * 8;
#pragma unroll
  for (int d0 = 0; d0 < 8; ++d0) qr[d0] = *reinterpret_cast<const bf16x8*>(Qw + d0 * 16);
  const int sr = tid >> 4, sc = (tid & 15) * 8, vst0 = v_st(sr, sc), vst1 = v_st(32 + sr, sc);
  const int vb0 = (int)(uintptr_t)V_lds + v_rd_base(lane);
  struct { bf16x8 vs0, vs1, ks0, ks1; } sr_[2];
#define SLOAD(i, k0) do { sr_[i].vs0 = *(const bf16x8*)(&Vh[(long)((k0) + sr) * LDK + sc]); sr_[i].vs1 = *(const bf16x8*)(&Vh[(long)((k0) + 32 + sr) * LDK + sc]); \
    sr_[i].ks0 = *(const bf16x8*)(&Kh[(long)((k0) + sr) * LDK + sc]); sr_[i].ks1 = *(const bf16x8*)(&Kh[(long)((k0) + 32 + sr) * LDK + sc]); } while (0)
#define SWRITE(b, i) do { *(bf16x8*)((char*)V_lds + (b) * SHM_V + vst0) = sr_[i].vs0;          \
    *(bf16x8*)((char*)V_lds + (b) * SHM_V + vst1) = sr_[i].vs1; int kc = sc * 2;               \
    *(bf16x8*)((char*)K_lds + (b) * SHM_K + KSWZ(sr, kc)) = sr_[i].ks0;                       \
    *(bf16x8*)((char*)K_lds + (b) * SHM_K + KSWZ(32 + sr, kc)) = sr_[i].ks1; } while (0)
#define SWAIT() asm volatile("s_waitcnt vmcnt(4)" ::: "memory")
#define RESC(a) do { if (__any((a) < 1.f)) { if (hi == 0) al_l[r32] = (a); asm volatile("s_waitcnt lgkmcnt(0)" ::: "memory"); \
    _Pragma("unroll") for (int d = 0; d < 4; ++d) _Pragma("unroll") for (int r = 0; r < 16; ++r) o[d][r] *= al_l[crow(r, hi)]; } } while (0)
  f32x16 pA0, pA1, pB0, pB1; float mnA, mnB, alA, alB; bf16x8 pa0, pa1, pa2, pa3; const int NT = seq / KVBLK;
  constexpr int SE = 0, SO = 1;
  SLOAD(SE, 0); asm volatile("s_waitcnt vmcnt(0)" ::: "memory"); SWRITE(0, SE); __syncthreads();
  qkt(pA0, pA1, K_lds, qr, r32, hi); partialSM(pA0, pA1, m_reg, mnA, alA);
  SLOAD(SO, KVBLK); if (2 < NT) SLOAD(SE, 2 * KVBLK);
  SWAIT(); SWRITE(1, SO); __syncthreads();
  for (int j = 1; j + 1 < NT; j += 2) {
    SBAR(); qkt(pB0, pB1, (bf16_t*)((char*)K_lds + SHM_K), qr, r32, hi);
    finishSM(pA0, pA1, alA, l_reg, pa0, pa1, pa2, pa3); SBAR();
    SLOAD(SO, (j + 2) * KVBLK); SBAR();
    pv_d0(o, vb0, pa0, pa1, pa2, pa3); partialSM(pB0, pB1, m_reg, mnB, alB);
    __syncthreads(); SWAIT(); SWRITE(0, SE);
    RESC(alB); __syncthreads();
    SBAR(); qkt(pA0, pA1, K_lds, qr, r32, hi);
    finishSM(pB0, pB1, alB, l_reg, pa0, pa1, pa2, pa3); SBAR();
    if (j + 3 < NT) SLOAD(SE, (j + 3) * KVBLK); SBAR();
    pv_d0(o, vb0 + (int)SHM_V, pa0, pa1, pa2, pa3); partialSM(pA0, pA1, m_reg, mnA, alA);
    __syncthreads(); SWAIT(); SWRITE(1, SO);
    RESC(alA); __syncthreads();
  }
  SBAR(); qkt(pB0, pB1, (bf16_t*)((char*)K_lds + SHM_K), qr, r32, hi);
  finishSM(pA0, pA1, alA, l_reg, pa0, pa1, pa2, pa3); SBAR();
  pv_d0(o, vb0, pa0, pa1, pa2, pa3); partialSM(pB0, pB1, m_reg, mnB, alB);
  __syncthreads(); RESC(alB);
  finishSM(pB0, pB1, alB, l_reg, pa0, pa1, pa2, pa3); SBAR();
  pv_d0(o, vb0 + (int)SHM_V, pa0, pa1, pa2, pa3);
  if (hi == 0) li_l[r32] = l_reg; asm volatile("s_waitcnt lgkmcnt(0)" ::: "memory");
  float rli[16];
#pragma unroll
  for (int r = 0; r < 16; ++r) rli[r] = __builtin_amdgcn_rcpf(li_l[crow(r, hi)]);
  bf16_t* Ow = Ob + (long)(wid * QBLK) * LDO;
#pragma unroll
  for (int r = 0; r < 16; ++r) { int orow = crow(r, hi);
#pragma unroll
    for (int d0 = 0; d0 < 4; ++d0) Ow[(long)orow * LDO + d0 * 32 + r32] = f2bf(o[d0][r] * rli[r]); }
#undef SLOAD
#undef SWRITE
#undef SWAIT
#undef RESC
}
}

__device__ __forceinline__ void transpose_tile(const float* __restrict__ W, bf16_t* __restrict__ Wt, int K, int N, int tk, int tn, float* tile, bool is_win) {
    const int tid = threadIdx.x;
    float4 v[8];
#pragma unroll
    for (int i = 0; i < 8; ++i) { const f32x4 t4 = __builtin_nontemporal_load((const f32x4*)(W + (size_t)(tk * 64 + (tid >> 6) + 8 * i) * N + tn * 256 + (tid & 63) * 4)); v[i] = (float4){t4[0], t4[1], t4[2], t4[3]}; }
#pragma unroll
    for (int i = 0; i < 8; ++i) { float* tp = tile + ((tid >> 6) + 8 * i) * 257 + (tid & 63) * 4; tp[0] = v[i].x; tp[1] = v[i].y; tp[2] = v[i].z; tp[3] = v[i].w; }
    __syncthreads();
    const int n = tid >> 1, k0 = (tid & 1) * 32; const int col = tn * 256 + n;
    const float s = (is_win && col >= C_KR && col < C_VR) ? 0.08838834764831845f : 1.f;
#pragma unroll
    for (int q = 0; q < 4; ++q) { float f[8];
#pragma unroll
        for (int j = 0; j < 8; ++j) f[j] = tile[(k0 + q * 8 + j) * 257 + n] * s;
        u32x4 w; w.x = cvt_pk_bf16(f[0], f[1]); w.y = cvt_pk_bf16(f[2], f[3]); w.z = cvt_pk_bf16(f[4], f[5]); w.w = cvt_pk_bf16(f[6], f[7]);
        *(u32x4*)(Wt + (size_t)col * K + tk * 64 + k0 + q * 8) = w; }
    __syncthreads();
}
__device__ __forceinline__ void cvt_stream(const float* __restrict__ src, bf16_t* __restrict__ dst, size_t n8, size_t gtid, size_t gthreads) {
    for (size_t i = gtid; i < n8; i += gthreads) {
        const float4 a = *(const float4*)(src + i * 8), b = *(const float4*)(src + i * 8 + 4);
        u32x4 w; w.x = cvt_pk_bf16(a.x, a.y); w.y = cvt_pk_bf16(a.z, a.w); w.z = cvt_pk_bf16(b.x, b.y); w.w = cvt_pk_bf16(b.z, b.w);
        *(u32x4*)(dst + i * 8) = w;
    }
}
__device__ __forceinline__ void phase_prep(const Params& p, unsigned char* smem) {
    const int tid = threadIdx.x, G = gridDim.x, bx = blockIdx.x;
    float* tile = (float*)smem;
    bf16_t* wtin = (bf16_t*)(p.ws + WS_WTIN); bf16_t* wto = (bf16_t*)(p.ws + WS_WTO); bf16_t* wtq = (bf16_t*)(p.ws + WS_WTQ);
    constexpr int T_IN = 32 * 22, T_O = 32 * 8;
    for (int t = bx; t < T_IN + 2 * T_O; t += G) {
        if (t < T_IN) transpose_tile(p.w_in, wtin, DM, NCOL, t / 22, t % 22, tile, true);
        else if (t < T_IN + T_O) { const int u = t - T_IN; transpose_tile(p.w_o, wto, DM, DM, u >> 3, u & 7, tile, false); }
        else { const int u = t - T_IN - T_O; transpose_tile(p.w_q, wtq, DM, DM, u >> 3, u & 7, tile, false); }
    }
    cvt_stream(p.sub_keys, (bf16_t*)(p.ws + WS_KEYS), 262144 / 8, (size_t)bx * NTHREADS + tid, (size_t)G * NTHREADS);
    float* mod = (float*)(p.ws + WS_MOD);
    for (int bi = bx; bi < 192; bi += G) {
        const int ks = bi / 6, cg4 = (bi % 6) * 512 + tid;
        __syncthreads();
        if (tid < 192) { const int c = tid >> 6, kk = tid & 63; const int k = ks * 64 + kk;
            const float v = (c == 0) ? p.c_ctx[k] : p.c[(c - 1) * DM + k]; tile[tid] = silu_f(v); }
        __syncthreads();
        float4 a0 = {0, 0, 0, 0}, a1 = a0, a2 = a0;
        const float* wp = p.w_ada + (size_t)(ks * 64) * 12288 + cg4 * 4;
#pragma unroll 8
        for (int kk = 0; kk < 64; ++kk) { const f32x4 w4 = __builtin_nontemporal_load((const f32x4*)(wp + (size_t)kk * 12288)); const float4 w = {w4[0], w4[1], w4[2], w4[3]};
            const float s0 = tile[kk], s1 = tile[64 + kk], s2 = tile[128 + kk];
            a0.x += s0 * w.x; a0.y += s0 * w.y; a0.z += s0 * w.z; a0.w += s0 * w.w;
            a1.x += s1 * w.x; a1.y += s1 * w.y; a1.z += s1 * w.z; a1.w += s1 * w.w;
            a2.x += s2 * w.x; a2.y += s2 * w.y; a2.z += s2 * w.z; a2.w += s2 * w.w; }
        if (ks == 0) { const float4 b = *(const float4*)(p.b_ada + cg4 * 4);
            a0.x += b.x; a0.y += b.y; a0.z += b.z; a0.w += b.w; a1.x += b.x; a1.y += b.y; a1.z += b.z; a1.w += b.w; a2.x += b.x; a2.y += b.y; a2.z += b.z; a2.w += b.w; }
        float* m0 = mod + cg4 * 4;
        atomicAdd(m0 + 0, a0.x); atomicAdd(m0 + 1, a0.y); atomicAdd(m0 + 2, a0.z); atomicAdd(m0 + 3, a0.w);
        atomicAdd(m0 + 12288 + 0, a1.x); atomicAdd(m0 + 12288 + 1, a1.y); atomicAdd(m0 + 12288 + 2, a1.z); atomicAdd(m0 + 12288 + 3, a1.w);
        atomicAdd(m0 + 24576 + 0, a2.x); atomicAdd(m0 + 24576 + 1, a2.y); atomicAdd(m0 + 24576 + 2, a2.z); atomicAdd(m0 + 24576 + 3, a2.w);
    }
    __syncthreads();
}

__device__ __forceinline__ void phase_h1(const Params& p) {
    const size_t gtid = (size_t)blockIdx.x * NTHREADS + threadIdx.x, gth = (size_t)gridDim.x * NTHREADS;
    const float* mod = (const float*)(p.ws + WS_MOD); bf16_t* H = (bf16_t*)(p.ws + WS_H);
    constexpr size_t NG = (size_t)TT * (DM / 8);
    for (size_t i0 = gtid; i0 < NG; i0 += 4 * gth) {
        float4 xa[4], xb[4];
#pragma unroll
        for (int u = 0; u < 4; ++u) { const size_t i = i0 + u * gth; if (i < NG) { const int t = (int)(i >> 8), c8 = (int)(i & 255) * 8; const float* xr = x_row(p, t) + c8;
            const f32x4 xa4 = __builtin_nontemporal_load((const f32x4*)xr), xb4 = __builtin_nontemporal_load((const f32x4*)(xr + 4)); xa[u] = (float4){xa4[0], xa4[1], xa4[2], xa4[3]}; xb[u] = (float4){xb4[0], xb4[1], xb4[2], xb4[3]}; } }
#pragma unroll
        for (int u = 0; u < 4; ++u) { const size_t i = i0 + u * gth; if (i < NG) { const int t = (int)(i >> 8), c8 = (int)(i & 255) * 8; const float* m = mod + (size_t)cond_of(t) * 12288;
            const float4 sha = *(const float4*)(m + c8), shb = *(const float4*)(m + c8 + 4);
            const float4 sca = *(const float4*)(m + 2048 + c8), scb = *(const float4*)(m + 2048 + c8 + 4);
            u32x4 w;
            w.x = cvt_pk_bf16(xa[u].x * (1.f + sca.x) + sha.x, xa[u].y * (1.f + sca.y) + sha.y);
            w.y = cvt_pk_bf16(xa[u].z * (1.f + sca.z) + sha.z, xa[u].w * (1.f + sca.w) + sha.w);
            w.z = cvt_pk_bf16(xb[u].x * (1.f + scb.x) + shb.x, xb[u].y * (1.f + scb.y) + shb.y);
            w.w = cvt_pk_bf16(xb[u].z * (1.f + scb.z) + shb.z, xb[u].w * (1.f + scb.w) + shb.w);
            *(u32x4*)(H + (size_t)t * DM + c8) = w; } }
    }
}

__device__ __forceinline__ void phase_postproj(const Params& p) {
    const int lane = threadIdx.x & 63; const int gw = blockIdx.x * 8 + (threadIdx.x >> 6), nw = gridDim.x * 8;
    bf16_t* P = (bf16_t*)(p.ws + WS_A);
    bf16_t* KC = (bf16_t*)(p.ws + WS_KC); bf16_t* VC = (bf16_t*)(p.ws + WS_VC); bf16_t* KL = (bf16_t*)(p.ws + WS_KL); bf16_t* VL = (bf16_t*)(p.ws + WS_VL);
    const int grp = lane >> 4, l16 = lane & 15, d0 = l16 * 8, sec = l16 >> 2;
    float invf[8], qg[8], kg[8];
#pragma unroll
    for (int i = 0; i < 8; ++i) { invf[i] = exp2f(-(float)((l16 & 3) * 8 + i) * (13.287712379549449f / 32.f)) * 0.15915494309189535f;
        qg[i] = p.qn_g[d0 + i]; kg[i] = p.kn_g[d0 + i]; }
    for (int t = gw; t < TT; t += nw) {
        const bool lat = t >= TP; const int tl = lat ? t - TP : t;
        bf16_t* rowp = P + (size_t)t * NCOL;
        const u32x4 wa = *(const u32x4*)(rowp + C_QA + grp * 128 + d0), wb = *(const u32x4*)(rowp + C_QA + (grp + 4) * 128 + d0), wc = *(const u32x4*)(rowp + C_KA + grp * 128 + d0);
        float cs[8], sn[8];
        if (lat) { const int l = tl & 4095; const float pos = (float)(sec < 2 ? (l >> 6) : (l & 63));
#pragma unroll
            for (int i = 0; i < 8; ++i) { const float rev = pos * invf[i]; const float fr = rev - floorf(rev); sn[i] = __builtin_amdgcn_sinf(fr); cs[i] = __builtin_amdgcn_cosf(fr); } }
        else {
#pragma unroll
            for (int i = 0; i < 8; ++i) { cs[i] = 1.f; sn[i] = 0.f; } }
        const float sgn = (sec & 1) ? 1.f : -1.f;
        float xa[8], xb[8], xc[8];
#pragma unroll
        for (int e = 0; e < 4; ++e) { xa[2 * e] = bf_lo(wa[e]); xa[2 * e + 1] = bf_hi(wa[e]); xb[2 * e] = bf_lo(wb[e]); xb[2 * e + 1] = bf_hi(wb[e]); xc[2 * e] = bf_lo(wc[e]); xc[2 * e + 1] = bf_hi(wc[e]); }
        float sa = 0.f, sb = 0.f, sc2 = 0.f;
#pragma unroll
        for (int i = 0; i < 8; ++i) { sa += xa[i] * xa[i]; sb += xb[i] * xb[i]; sc2 += xc[i] * xc[i]; }
#pragma unroll
        for (int o = 1; o < 16; o <<= 1) { sa += __shfl_xor(sa, o); sb += __shfl_xor(sb, o); sc2 += __shfl_xor(sc2, o); }
        const float ra = rsqrtf(sa * (1.f / 128.f) + EPS), rb = rsqrtf(sb * (1.f / 128.f) + EPS), rc = rsqrtf(sc2 * (1.f / 128.f) + EPS);
        float oa[8], ob[8], oc[8];
#pragma unroll
        for (int i = 0; i < 8; ++i) { const float ya = xa[i] * ra * qg[i], yb = xb[i] * rb * qg[i], yc = xc[i] * rc * kg[i];
            const float za = __shfl_xor(ya, 4), zb = __shfl_xor(yb, 4), zc = __shfl_xor(yc, 4);
            oa[i] = ya * cs[i] + sgn * za * sn[i]; ob[i] = yb * cs[i] + sgn * zb * sn[i]; oc[i] = yc * cs[i] + sgn * zc * sn[i]; }
        u32x4 pa, pb, pc;
#pragma unroll
        for (int e = 0; e < 4; ++e) { pa[e] = cvt_pk_bf16(oa[2 * e], oa[2 * e + 1]); pb[e] = cvt_pk_bf16(ob[2 * e], ob[2 * e + 1]); pc[e] = cvt_pk_bf16(oc[2 * e], oc[2 * e + 1]); }
        *(u32x4*)(rowp + C_QA + grp * 128 + d0) = pa; *(u32x4*)(rowp + C_QA + (grp + 4) * 128 + d0) = pb;
        const int kvh = grp & 1; const bool isk = grp < 2;
        const u32x4 outw = isk ? pc : wc;
        if (!lat) { const int b = tl >> 8, pos = tl & 255;
            bf16_t* dst = (isk ? KC : VC) + ((size_t)(b * 2 + kvh) * 256 + pos) * 128 + d0; *(u32x4*)dst = outw;
            float* od = p.out + (isk ? O_CK : O_CV) + ((size_t)(b * 256 + pos) * 2 + kvh) * 128 + d0;
            float4 f0, f1;
            if (isk) { f0 = (float4){oc[0], oc[1], oc[2], oc[3]}; f1 = (float4){oc[4], oc[5], oc[6], oc[7]}; }
            else { f0 = (float4){xc[0], xc[1], xc[2], xc[3]}; f1 = (float4){xc[4], xc[5], xc[6], xc[7]}; }
            *(float4*)od = f0; *(float4*)(od + 4) = f1;
        } else { const int b = tl >> 12, l = tl & 4095;
            bf16_t* dst = (isk ? KL : VL) + ((size_t)(b * 2 + kvh) * SKV_L + 256 + l) * 128 + d0; *(u32x4*)dst = outw; }
    }
    for (int task = gw; task < 2 * 256 * 2; task += nw) {
        const int b = task >> 9, pos = (task >> 1) & 255, kvh = task & 1;
        const float* ck = p.cache_k + ((size_t)(b * 256 + pos) * 2 + kvh) * 128; const float* cv = p.cache_v + ((size_t)(b * 256 + pos) * 2 + kvh) * 128;
        bf16_t* kd = KL + ((size_t)(b * 2 + kvh) * SKV_L + pos) * 128; bf16_t* vd = VL + ((size_t)(b * 2 + kvh) * SKV_L + pos) * 128;
        kd[lane] = f2bf(ck[lane]); kd[lane + 64] = f2bf(ck[lane + 64]); vd[lane] = f2bf(cv[lane]); vd[lane + 64] = f2bf(cv[lane + 64]);
    }
}

struct RetItem { int tok0, h, seqk; };
__device__ __forceinline__ void ret_item(int it, int& tok0, int& h) {
    if (it < 256) { const int s = it >> 4; h = (it >> 1) & 7; tok0 = s * 256 + (it & 1) * 128; }
    else { const int u = it - 256; const int s = u >> 8; h = (u >> 5) & 7; tok0 = TP + s * 4096 + (u & 31) * 128; }
}
constexpr int RS = 136;

__device__ __forceinline__ void phase_chunk_kv(const Params& p, unsigned char* smem) {
    const int tid = threadIdx.x, lane = tid & 63, wid = tid >> 6, fr = lane & 15, fq = lane >> 4;
    const bf16_t* P = (const bf16_t*)(p.ws + WS_A); bf16_t* KVC = (bf16_t*)(p.ws + WS_B);
    bf16_t* KT = (bf16_t*)smem; bf16_t* VFT = KT + 128 * RS; bf16_t* VBT = VFT + 128 * RS;
    for (int it = blockIdx.x; it < 768; it += gridDim.x) {
        int tok0, h; ret_item(it, tok0, h);
        const float lgf = log_sigmoid(p.decay[h]), lgb = log_sigmoid(p.decay[8 + h]);
        { const int j = tid & 127, dq = tid >> 7;
          const float zf = __expf(lgf * (float)(127 - j)), zb = __expf(lgb * (float)j);
          const bf16_t* kp = P + (size_t)(tok0 + j) * NCOL + C_KR + h * 128 + dq * 32; const bf16_t* vp = P + (size_t)(tok0 + j) * NCOL + C_VR + h * 128 + dq * 32;
          u32x4 kwv[4], vwv[4];
#pragma unroll
          for (int q = 0; q < 4; ++q) { kwv[q] = *(const u32x4*)(kp + q * 8); vwv[q] = *(const u32x4*)(vp + q * 8); }
          __syncthreads();
#pragma unroll
          for (int q = 0; q < 4; ++q) { const u32x4 kw = kwv[q]; const u32x4 vw = vwv[q];
              bf16_t* kt = KT + (dq * 32 + q * 8) * RS + j; bf16_t* vf = VFT + (dq * 32 + q * 8) * RS + j; bf16_t* vb = VBT + (dq * 32 + q * 8) * RS + j;
#pragma unroll
              for (int e = 0; e < 4; ++e) {
                  kt[(2 * e) * RS] = (bf16_t)(kw[e] & 0xffffu); kt[(2 * e + 1) * RS] = (bf16_t)(kw[e] >> 16);
                  const float v0 = bf_lo(vw[e]), v1 = bf_hi(vw[e]);
                  vf[(2 * e) * RS] = f2bf(v0 * zf); vf[(2 * e + 1) * RS] = f2bf(v1 * zf);
                  vb[(2 * e) * RS] = f2bf(v0 * zb); vb[(2 * e + 1) * RS] = f2bf(v1 * zb); } } }
        __syncthreads();
        const int dir = wid >> 2, n0 = (wid & 3) * 32; const bf16_t* VT = dir ? VBT : VFT;
        f32x4 acc[8][2];
#pragma unroll
        for (int m = 0; m < 8; ++m) { acc[m][0] = (f32x4){0, 0, 0, 0}; acc[m][1] = (f32x4){0, 0, 0, 0}; }
#pragma unroll 1
        for (int ks = 0; ks < 4; ++ks) {
            const bf16x8 b0 = *(const bf16x8*)(VT + (n0 + fr) * RS + ks * 32 + fq * 8), b1 = *(const bf16x8*)(VT + (n0 + 16 + fr) * RS + ks * 32 + fq * 8);
            const bf16_t* ap = KT + fr * RS + ks * 32 + fq * 8;
#pragma unroll
            for (int m = 0; m < 8; ++m) { const bf16x8 a = *(const bf16x8*)(ap + m * 16 * RS);
                acc[m][0] = __builtin_amdgcn_mfma_f32_16x16x32_bf16(a, b0, acc[m][0], 0, 0, 0);
                acc[m][1] = __builtin_amdgcn_mfma_f32_16x16x32_bf16(a, b1, acc[m][1], 0, 0, 0); } }
        bf16_t* dst = KVC + ((size_t)it * 2 + dir) * 16384;
#pragma unroll
        for (int m = 0; m < 8; ++m)
#pragma unroll
            for (int n = 0; n < 2; ++n)
#pragma unroll
                for (int r = 0; r < 4; ++r) dst[(m * 16 + fq * 4 + r) * 128 + n0 + n * 16 + fr] = f2bf(acc[m][n][r]);
    }
    __syncthreads();
}

__device__ __forceinline__ void phase_scan(const Params& p) {
    const int gtid = blockIdx.x * NTHREADS + threadIdx.x, gth = gridDim.x * NTHREADS;
    const bf16_t* KVC = (const bf16_t*)(p.ws + WS_B); bf16_t* SP = (bf16_t*)(p.ws + WS_D);
    for (int u = gtid; u < 32 * 4096; u += gth) {
        const int sq = u >> 12, e4 = (u & 4095) * 4; const int b = sq >> 4, h = (sq >> 1) & 7, dir = sq & 1;
        const float g128 = __expf(128.f * log_sigmoid(p.decay[dir * 8 + h]));
        float4 S = *(const float4*)(p.state_ret + ((size_t)(b * 2 + dir) * 8 + h) * 16384 + e4);
        const int it0 = 256 + (b * 8 + h) * 32;
#pragma unroll 8
        for (int st = 0; st < 32; ++st) { const int c = dir ? 31 - st : st; const size_t o = ((size_t)(it0 + c) * 2 + dir) * 16384 + e4;
            const u32x2 kvw = *(const u32x2*)(KVC + o); const float4 kv = {bf_lo(kvw.x), bf_hi(kvw.x), bf_lo(kvw.y), bf_hi(kvw.y)};
            u32x2 w; w.x = cvt_pk_bf16(S.x, S.y); w.y = cvt_pk_bf16(S.z, S.w); *(u32x2*)(SP + o) = w;
            S.x = g128 * S.x + kv.x; S.y = g128 * S.y + kv.y; S.z = g128 * S.z + kv.z; S.w = g128 * S.w + kv.w; }
    }
    for (int u = gtid; u < 256 * 4096; u += gth) {
        const int sq = u >> 12, e4 = (u & 4095) * 4; const int s = sq >> 4, h = (sq >> 1) & 7, dir = sq & 1;
        const float g128 = __expf(128.f * log_sigmoid(p.decay[dir * 8 + h]));
        const int it0 = (s * 8 + h) * 2;
        const int cfirst = dir ? 1 : 0, csecond = dir ? 0 : 1;
        const size_t o1 = ((size_t)(it0 + cfirst) * 2 + dir) * 16384 + e4, o2 = ((size_t)(it0 + csecond) * 2 + dir) * 16384 + e4;
        const u32x2 k1w = *(const u32x2*)(KVC + o1), k2w = *(const u32x2*)(KVC + o2);
        const float4 k1 = {bf_lo(k1w.x), bf_hi(k1w.x), bf_lo(k1w.y), bf_hi(k1w.y)}, k2 = {bf_lo(k2w.x), bf_hi(k2w.x), bf_lo(k2w.y), bf_hi(k2w.y)};
        u32x2 z; z.x = 0u; z.y = 0u; *(u32x2*)(SP + o1) = z;
        *(u32x2*)(SP + o2) = k1w;
        float4 f; f.x = g128 * k1.x + k2.x; f.y = g128 * k1.y + k2.y; f.z = g128 * k1.z + k2.z; f.w = g128 * k1.w + k2.w;
        *(float4*)(p.out + O_STATE + ((size_t)(s * 2 + dir) * 8 + h) * 16384 + e4) = f;
    }
}

__device__ __forceinline__ void phase_attention(const Params& p, unsigned char* smem) {
    const bf16_t* P = (const bf16_t*)(p.ws + WS_A); bf16_t* MIX = (bf16_t*)(p.ws + WS_E);
    const bf16_t* KC = (const bf16_t*)(p.ws + WS_KC); const bf16_t* VC = (const bf16_t*)(p.ws + WS_VC);
    const bf16_t* KL = (const bf16_t*)(p.ws + WS_KL); const bf16_t* VL = (const bf16_t*)(p.ws + WS_VL);
    for (int it = blockIdx.x; it < 384; it += gridDim.x) {
        __syncthreads();
        if (it < 256) { const int b = it >> 7, h = (it >> 4) & 7, qb = it & 15; const int tok0 = TP + b * 4096 + qb * 256; const int kvh = h >> 2;
            att::attn_dense_body<NCOL, 128, DM>(P + (size_t)tok0 * NCOL + C_QA + h * 128, KL + (size_t)(b * 2 + kvh) * SKV_L * 128, VL + (size_t)(b * 2 + kvh) * SKV_L * 128,
                                                MIX + (size_t)tok0 * DM + 1024 + h * 128, SKV_L, (char*)smem);
        } else { const int u = it - 256; const int b = u >> 3, h = u & 7; const int tok0 = b * 256; const int kvh = h >> 2;
            att::attn_dense_body<NCOL, 128, DM>(P + (size_t)tok0 * NCOL + C_QA + h * 128, KC + (size_t)(b * 2 + kvh) * 256 * 128, VC + (size_t)(b * 2 + kvh) * 256 * 128,
                                                MIX + (size_t)tok0 * DM + 1024 + h * 128, 256, (char*)smem);
        }
    }
    __syncthreads();
}

__device__ __forceinline__ void phase_ret_out(const Params& p, unsigned char* smem) {
    const int tid = threadIdx.x, lane = tid & 63, wid = tid >> 6, fr = lane & 15, fq = lane >> 4;
    const bf16_t* P = (const bf16_t*)(p.ws + WS_A); const bf16_t* SP = (const bf16_t*)(p.ws + WS_D); bf16_t* MIX = (bf16_t*)(p.ws + WS_E);
    bf16_t* KN = (bf16_t*)smem; bf16_t* VT = KN + 128 * RS; bf16_t* SFT = VT + 128 * RS; bf16_t* SBT = SFT + 128 * RS;
    for (int it = blockIdx.x; it < 768; it += gridDim.x) {
        int tok0, h; ret_item(it, tok0, h);
        const float lgf = log_sigmoid(p.decay[h]), lgb = log_sigmoid(p.decay[8 + h]);
        { u32x4 kq[4];
#pragma unroll
          for (int q = 0; q < 4; ++q) kq[q] = *(const u32x4*)(P + (size_t)(tok0 + (tid >> 4) + 32 * q) * NCOL + C_KR + h * 128 + (tid & 15) * 8);
          const int j = tid & 127, dq = tid >> 7;
          const bf16_t* vp = P + (size_t)(tok0 + j) * NCOL + C_VR + h * 128 + dq * 32;
          const bf16_t* sf = SP + ((size_t)it * 2 + 0) * 16384 + j * 128 + dq * 32; const bf16_t* sb = SP + ((size_t)it * 2 + 1) * 16384 + j * 128 + dq * 32;
          u32x4 vwv[4], fwv[4], bwv[4];
#pragma unroll
          for (int q = 0; q < 4; ++q) { vwv[q] = *(const u32x4*)(vp + q * 8); fwv[q] = *(const u32x4*)(sf + q * 8); bwv[q] = *(const u32x4*)(sb + q * 8); }
          __syncthreads();
#pragma unroll
          for (int q = 0; q < 4; ++q) *(u32x4*)(KN + ((tid >> 4) + 32 * q) * RS + (tid & 15) * 8) = kq[q];
#pragma unroll
          for (int q = 0; q < 4; ++q) { const u32x4 vw = vwv[q], fw = fwv[q], bw = bwv[q];
              bf16_t* vt = VT + (dq * 32 + q * 8) * RS + j; bf16_t* ft = SFT + (dq * 32 + q * 8) * RS + j; bf16_t* bt = SBT + (dq * 32 + q * 8) * RS + j;
#pragma unroll
              for (int e = 0; e < 4; ++e) {
                  vt[(2 * e) * RS] = (bf16_t)(vw[e] & 0xffffu); vt[(2 * e + 1) * RS] = (bf16_t)(vw[e] >> 16);
                  ft[(2 * e) * RS] = (bf16_t)(fw[e] & 0xffffu); ft[(2 * e + 1) * RS] = (bf16_t)(fw[e] >> 16);
                  bt[(2 * e) * RS] = (bf16_t)(bw[e] & 0xffffu); bt[(2 * e + 1) * RS] = (bf16_t)(bw[e] >> 16); } } }
        const int i0 = wid * 16;
        bf16x8 qf[4], qxf[4], qxb[4];
        { const float xf = __expf(lgf * (float)(i0 + fr + 1)), xb = __expf(lgb * (float)(128 - (i0 + fr)));
#pragma unroll
          for (int ks = 0; ks < 4; ++ks) { const u32x4 w = *(const u32x4*)(P + (size_t)(tok0 + i0 + fr) * NCOL + C_QR + h * 128 + ks * 32 + fq * 8);
              qf[ks] = *reinterpret_cast<const bf16x8*>(&w); u32x4 wf, wb;
#pragma unroll
              for (int e = 0; e < 4; ++e) { const float lo = bf_lo(w[e]), hi = bf_hi(w[e]); wf[e] = cvt_pk_bf16(lo * xf, hi * xf); wb[e] = cvt_pk_bf16(lo * xb, hi * xb); }
              qxf[ks] = *reinterpret_cast<bf16x8*>(&wf); qxb[ks] = *reinterpret_cast<bf16x8*>(&wb); } }
        __syncthreads();
        bf16x8 pa[4];
        {
            f32x4 sc[8];
#pragma unroll
            for (int mt = 0; mt < 8; ++mt) { sc[mt] = (f32x4){0, 0, 0, 0};
                const bf16_t* kp = KN + (mt * 16 + fr) * RS + fq * 8;
#pragma unroll
                for (int ks = 0; ks < 4; ++ks) { const bf16x8 a = *(const bf16x8*)(kp + ks * 32);
                    sc[mt] = __builtin_amdgcn_mfma_f32_16x16x32_bf16(a, qf[ks], sc[mt], 0, 0, 0); } }
            const int i = i0 + fr;
#pragma unroll
            for (int mt = 0; mt < 8; ++mt)
#pragma unroll
                for (int r = 0; r < 4; ++r) { const int j = mt * 16 + fq * 4 + r; const int df = i - j;
                    const float m = df > 0 ? __expf(lgf * (float)df) : (df < 0 ? __expf(lgb * (float)(-df)) : 2.f);
                    sc[mt][r] *= m; }
#pragma unroll
            for (int s = 0; s < 4; ++s) { u32x4 w; w.x = cvt_pk_bf16(sc[2 * s][0], sc[2 * s][1]); w.y = cvt_pk_bf16(sc[2 * s][2], sc[2 * s][3]);
                w.z = cvt_pk_bf16(sc[2 * s + 1][0], sc[2 * s + 1][1]); w.w = cvt_pk_bf16(sc[2 * s + 1][2], sc[2 * s + 1][3]); pa[s] = *reinterpret_cast<bf16x8*>(&w); }
        }
        f32x4 oa[8];
#pragma unroll
        for (int nt = 0; nt < 8; ++nt) { oa[nt] = (f32x4){0, 0, 0, 0};
            const int dv = nt * 16 + fr;
#pragma unroll
            for (int s = 0; s < 4; ++s) {
                const u32x2 lo = *(const u32x2*)(VT + dv * RS + s * 32 + fq * 4), hi = *(const u32x2*)(VT + dv * RS + s * 32 + 16 + fq * 4);
                u32x4 bw; bw.x = lo.x; bw.y = lo.y; bw.z = hi.x; bw.w = hi.y;
                oa[nt] = __builtin_amdgcn_mfma_f32_16x16x32_bf16(pa[s], *reinterpret_cast<bf16x8*>(&bw), oa[nt], 0, 0, 0);
                const bf16x8 bf = *(const bf16x8*)(SFT + dv * RS + s * 32 + fq * 8), bb = *(const bf16x8*)(SBT + dv * RS + s * 32 + fq * 8);
                oa[nt] = __builtin_amdgcn_mfma_f32_16x16x32_bf16(qxf[s], bf, oa[nt], 0, 0, 0);
                oa[nt] = __builtin_amdgcn_mfma_f32_16x16x32_bf16(qxb[s], bb, oa[nt], 0, 0, 0); }
            asm volatile("" ::: "memory"); }
#pragma unroll
        for (int r = 0; r < 4; ++r) { const int i = i0 + fq * 4 + r;
            float s1 = 0.f;
#pragma unroll
            for (int nt = 0; nt < 8; ++nt) s1 += oa[nt][r];
            s1 += __shfl_xor(s1, 1); s1 += __shfl_xor(s1, 2); s1 += __shfl_xor(s1, 4); s1 += __shfl_xor(s1, 8);
            const float mu = s1 * (1.f / 128.f); float s2 = 0.f;
#pragma unroll
            for (int nt = 0; nt < 8; ++nt) { const float d = oa[nt][r] - mu; s2 += d * d; }
            s2 += __shfl_xor(s2, 1); s2 += __shfl_xor(s2, 2); s2 += __shfl_xor(s2, 4); s2 += __shfl_xor(s2, 8);
            const float rs = rsqrtf(s2 * (1.f / 128.f) + EPS);
            const bf16_t* gp = P + (size_t)(tok0 + i) * NCOL + C_GR + h * 128; bf16_t* op = MIX + (size_t)(tok0 + i) * DM + h * 128;
#pragma unroll
            for (int nt = 0; nt < 8; ++nt) { const int dv = nt * 16 + fr; const float g = bf2f(gp[dv]);
                op[dv] = f2bf((oa[nt][r] - mu) * rs * p.gn_g[h * 128 + dv] * silu_f(g)); } }
    }
    __syncthreads();
}


constexpr float U_SCALE = 90.f, V_SCALE = 9.5f;
constexpr int ROW4 = 1024;
__device__ __forceinline__ void cvt_fp4_table(const float* __restrict__ src, unsigned char* __restrict__ dst, float scale, size_t gtid, size_t gth) {
    bool swapped;
    { const unsigned cw = __builtin_amdgcn_cvt_scalef32_pk_fp4_f32(0u, 1.0f, -1.0f, 1.0f, 0);
      const f32x2 cr = __builtin_amdgcn_cvt_scalef32_pk_f32_fp4(cw, 1.0f, 0); swapped = cr.x < 0.f; }
    constexpr size_t NU = (size_t)16384 * 64;
    for (size_t i = gtid; i < NU; i += gth) {
        const size_t row = i >> 6; const int l = (int)i & 63;
        const float* sp = src + row * 2048 + l * 4;
        float f[32];
#pragma unroll
        for (int q = 0; q < 8; ++q) { const f32x4 xv = __builtin_nontemporal_load((const f32x4*)(sp + q * 256)); const float4 x = {xv[0], xv[1], xv[2], xv[3]};
            f[q * 4] = fminf(fmaxf(x.x * scale, -6.f), 6.f); f[q * 4 + 1] = fminf(fmaxf(x.y * scale, -6.f), 6.f); f[q * 4 + 2] = fminf(fmaxf(x.z * scale, -6.f), 6.f); f[q * 4 + 3] = fminf(fmaxf(x.w * scale, -6.f), 6.f); }
        u32x4 w;
#pragma unroll
        for (int qd = 0; qd < 4; ++qd) { unsigned ww = 0u;
            if (swapped) {
                ww = __builtin_amdgcn_cvt_scalef32_pk_fp4_f32(ww, f[qd * 8 + 1], f[qd * 8 + 0], 1.0f, 0); ww = __builtin_amdgcn_cvt_scalef32_pk_fp4_f32(ww, f[qd * 8 + 3], f[qd * 8 + 2], 1.0f, 1);
                ww = __builtin_amdgcn_cvt_scalef32_pk_fp4_f32(ww, f[qd * 8 + 5], f[qd * 8 + 4], 1.0f, 2); ww = __builtin_amdgcn_cvt_scalef32_pk_fp4_f32(ww, f[qd * 8 + 7], f[qd * 8 + 6], 1.0f, 3);
            } else {
                ww = __builtin_amdgcn_cvt_scalef32_pk_fp4_f32(ww, f[qd * 8 + 0], f[qd * 8 + 1], 1.0f, 0); ww = __builtin_amdgcn_cvt_scalef32_pk_fp4_f32(ww, f[qd * 8 + 2], f[qd * 8 + 3], 1.0f, 1);
                ww = __builtin_amdgcn_cvt_scalef32_pk_fp4_f32(ww, f[qd * 8 + 4], f[qd * 8 + 5], 1.0f, 2); ww = __builtin_amdgcn_cvt_scalef32_pk_fp4_f32(ww, f[qd * 8 + 6], f[qd * 8 + 7], 1.0f, 3);
            }
            w[qd] = ww; }
        *(u32x4*)(dst + row * ROW4 + l * 16) = w;
    }
}

__device__ __forceinline__ void phase_ln1(const Params& p) {
    const int lane = threadIdx.x & 63; const int gw = blockIdx.x * 8 + (threadIdx.x >> 6), nw = gridDim.x * 8;
    const bf16_t* Y = (const bf16_t*)(p.ws + WS_B); bf16_t* H = (bf16_t*)(p.ws + WS_H); const float* mod = (const float*)(p.ws + WS_MOD);
    for (int t = gw; t < TT; t += nw) {
        const bf16_t* yr = Y + (size_t)t * DM; const float* m = mod + (size_t)cond_of(t) * 12288;
        float4 v[8]; float s = 0.f;
#pragma unroll
        for (int c = 0; c < 8; ++c) { const u32x2 yw = *(const u32x2*)(yr + c * 256 + lane * 4); v[c] = (float4){bf_lo(yw.x), bf_hi(yw.x), bf_lo(yw.y), bf_hi(yw.y)}; s += (v[c].x + v[c].y) + (v[c].z + v[c].w); }
        const float mu = wave_sum(s) * (1.f / 2048.f); float q = 0.f;
#pragma unroll
        for (int c = 0; c < 8; ++c) { const float a = v[c].x - mu, b = v[c].y - mu, cc = v[c].z - mu, d = v[c].w - mu; q += (a * a + b * b) + (cc * cc + d * d); }
        const float rs = rsqrtf(wave_sum(q) * (1.f / 2048.f) + EPS);
#pragma unroll
        for (int c = 0; c < 8; ++c) { const int col = c * 256 + lane * 4;
            const float4 g = *(const float4*)(p.ln1_g + col), b = *(const float4*)(p.ln1_b + col);
            const float4 sh = *(const float4*)(m + 3 * 2048 + col), sc = *(const float4*)(m + 4 * 2048 + col);
            float4 x1; x1.x = (v[c].x - mu) * rs * g.x + b.x; x1.y = (v[c].y - mu) * rs * g.y + b.y; x1.z = (v[c].z - mu) * rs * g.z + b.z; x1.w = (v[c].w - mu) * rs * g.w + b.w;
            u32x2 w; w.x = cvt_pk_bf16(x1.x * (1.f + sc.x) + sh.x, x1.y * (1.f + sc.y) + sh.y); w.y = cvt_pk_bf16(x1.z * (1.f + sc.z) + sh.z, x1.w * (1.f + sc.w) + sh.w);
            *(u32x2*)(H + (size_t)t * DM + col) = w; }
        if (lane == 0) *(float2*)(p.ws + WS_STATS + (size_t)t * 8) = (float2){mu, rs};
    }
}

#define XB_TMO      128
#define XB_XCNT(j)  (256  + 64 * (j))
#define XB_XSUB(j)  (1280 + 64 * (j))
#define XB_XGEN(j)  (2304 + 64 * (j))
#define XB_TOP      3328
#define XB_TOPGEN   3392
#define XCD_BAR_WORDS 3456
#define XB_SPIN_CAP (1u << 18)
__device__ __forceinline__ unsigned xb_ld(unsigned* p)              { return __hip_atomic_load(p, __ATOMIC_RELAXED, __HIP_MEMORY_SCOPE_AGENT); }
__device__ __forceinline__ unsigned xb_add(unsigned* p, unsigned v) { return __hip_atomic_fetch_add(p, v, __ATOMIC_RELAXED, __HIP_MEMORY_SCOPE_AGENT); }
__device__ __forceinline__ unsigned xb_xcc_id() { return (unsigned)__builtin_amdgcn_s_getreg((3 << 11) | 20) & 0xFu; }
#define XB_SPIN(cond, bar) do { unsigned _sp = 0; while (cond) { __builtin_amdgcn_s_sleep(1); \
    if ((++_sp & 255u) == 0u) { if (xb_ld(&(bar)[XB_TMO])) break; if (_sp > XB_SPIN_CAP) { atomicAdd(&(bar)[XB_TMO], 1u); break; } } } } while (0)
struct XcdBarrier { unsigned* bar; unsigned x; volatile LAS unsigned* st; };
__device__ __forceinline__ XcdBarrier xcd_barrier_post(unsigned* bar, volatile LAS unsigned* st) {
    XcdBarrier b; b.bar = bar; b.x = xb_xcc_id(); b.st = st;
    if (threadIdx.x == 0) (void)xb_add(&bar[XB_XCNT(b.x)], 1u);
    return b;
}
__device__ __forceinline__ void xcd_barrier_complete(unsigned* bar, unsigned x, unsigned& nloc, unsigned& nx) {
    const unsigned G = gridDim.x * gridDim.y * gridDim.z;
    unsigned sum, cnt, mine, sp = 0u;
    for (;;) {
        sum = 0u; cnt = 0u; mine = 0u;
#pragma unroll
        for (unsigned j = 0; j < 16; ++j) { const unsigned c = xb_ld(&bar[XB_XCNT(j)]); sum += c; cnt += (c > 0u) ? 1u : 0u; mine = (j == x) ? c : mine; }
        if (sum == G) break;
        __builtin_amdgcn_s_sleep(1);
        if ((++sp & 255u) == 0u) { if (xb_ld(&bar[XB_TMO])) break; if (sp > XB_SPIN_CAP) { atomicAdd(&bar[XB_TMO], 1u); break; } }
    }
    nloc = mine > 0u ? mine : 1u; nx = cnt > 0u ? cnt : 1u;
}
__device__ __forceinline__ void xcd_barrier(const XcdBarrier& b) {
    asm volatile("s_waitcnt vmcnt(0)" ::: "memory");
    __syncthreads();
    if (threadIdx.x == 0) {
        unsigned* bar = b.bar;
        __builtin_amdgcn_s_waitcnt(0);
        unsigned nloc = b.st[0], nx = b.st[1];
        if (nloc == 0u) { xcd_barrier_complete(bar, b.x, nloc, nx); b.st[0] = nloc; b.st[1] = nx; }
        const unsigned old = xb_add(&bar[XB_XSUB(b.x)], 1u);
        const unsigned gen = old / nloc;
        if (old + 1u == (gen + 1u) * nloc) {
            __builtin_amdgcn_fence(__ATOMIC_RELEASE, "agent");
            asm volatile("s_waitcnt vmcnt(0)" ::: "memory");
            const unsigned og = xb_add(&bar[XB_TOP], 1u);
            const unsigned tg = og / nx;
            if (og + 1u == (tg + 1u) * nx) xb_add(&bar[XB_TOPGEN], 1u);
            else XB_SPIN(xb_ld(&bar[XB_TOPGEN]) == tg, bar);
            __builtin_amdgcn_fence(__ATOMIC_ACQUIRE, "agent");
            xb_add(&bar[XB_XGEN(b.x)], 1u);
            asm volatile("s_waitcnt vmcnt(0)" ::: "memory");
        } else {
            XB_SPIN(xb_ld(&bar[XB_XGEN(b.x)]) == gen, bar);
            __builtin_amdgcn_fence(__ATOMIC_ACQUIRE, "agent");
            asm volatile("s_waitcnt vmcnt(0)" ::: "memory");
        }
    }
    __syncthreads();
}
constexpr size_t WS_BAR = 3 * 12288 * 4;


__device__ __forceinline__ unsigned fkey(float v) { const unsigned u = __float_as_uint(v); return (u & 0x80000000u) ? ~u : (u | 0x80000000u); }
__device__ __forceinline__ float kval(unsigned k) { return __uint_as_float((k & 0x80000000u) ? (k & 0x7fffffffu) : ~k); }
__device__ __forceinline__ int bitrev4(int x) { return ((x & 1) << 3) | ((x & 2) << 1) | ((x & 4) >> 1) | ((x & 8) >> 3); }
#define TOPK_INSERT(top, key) do { unsigned _k = (key); _Pragma("unroll") for (int _s = 0; _s < 16; ++_s) { const unsigned _hi = top[_s] > _k ? top[_s] : _k; _k = top[_s] > _k ? _k : top[_s]; top[_s] = _hi; } } while (0)

__device__ __forceinline__ void phase_peer(const Params& p, unsigned char* smem, const XcdBarrier& xbar) {
    const int tid = threadIdx.x, lane = tid & 63, wid = tid >> 6, fr = lane & 15, fq = lane >> 4;
    const bf16_t* PQ = (const bf16_t*)(p.ws + WS_D); const bf16_t* KEYS = (const bf16_t*)(p.ws + WS_KEYS);
    const bf16_t* H = (const bf16_t*)(p.ws + WS_H); const bf16_t* X1 = (const bf16_t*)(p.ws + WS_B); const float* mod = (const float*)(p.ws + WS_MOD);
    int* SELI = (int*)(p.ws + WS_SEL); float* SELG = (float*)(p.ws + WS_SEL + (size_t)TT * 128 * 4);
    float* sc = (float*)smem;
    unsigned* tl = (unsigned*)(smem + 256 * 129 * 4);
    const int ntok = TT / gridDim.x;
    const int tbase = blockIdx.x * ntok;
#ifndef PEER_NO_TOPK
    for (int b0 = 0; b0 < ntok; b0 += 16) {
        {
            const int trow = tbase + b0 + fr; const bool tv = (b0 + fr) < ntok;
#pragma unroll
            for (int pp = 0; pp < 2; ++pp) {
                bf16x8 a[4];
#pragma unroll
                for (int ks = 0; ks < 4; ++ks) a[ks] = tv ? *(const bf16x8*)(PQ + (size_t)trow * DM + wid * 256 + pp * 128 + ks * 32 + fq * 8) : (bf16x8){0, 0, 0, 0, 0, 0, 0, 0};
#pragma unroll
                for (int nt = 0; nt < 8; ++nt) { f32x4 acc = {0, 0, 0, 0};
#pragma unroll
                    for (int ks = 0; ks < 4; ++ks) { const bf16x8 bk = *(const bf16x8*)(KEYS + ((size_t)(wid * 2 + pp) * 128 + nt * 16 + fr) * 128 + ks * 32 + fq * 8);
                        acc = __builtin_amdgcn_mfma_f32_16x16x32_bf16(a[ks], bk, acc, 0, 0, 0); }
#pragma unroll
                    for (int r = 0; r < 4; ++r) sc[(((fq * 4 + r) * 8 + wid) * 2 + pp) * 129 + nt * 16 + fr] = acc[r]; }
            }
        }
        __syncthreads();
        if (tid < 256) {
            unsigned top[16];
            const float* lp = sc + tid * 129;
#define CE_DESC(a, b) do { const unsigned _hi = max(a, b), _lo = min(a, b); a = _hi; b = _lo; } while (0)
#define CE_ASC(a, b)  do { const unsigned _hi = max(a, b), _lo = min(a, b); a = _lo; b = _hi; } while (0)
#define SORT16_DESC(v) do { _Pragma("unroll") for (int _k = 2; _k <= 16; _k <<= 1) _Pragma("unroll") for (int _j = _k >> 1; _j > 0; _j >>= 1) _Pragma("unroll") for (int _i = 0; _i < 16; ++_i) { \
                const int _l = _i ^ _j; if (_l > _i) { if ((_i & _k) == 0) CE_DESC(v[_i], v[_l]); else CE_ASC(v[_i], v[_l]); } } } while (0)
#pragma unroll
            for (int i = 0; i < 16; ++i) top[i] = (fkey(lp[i]) & ~127u) | (unsigned)(127 - i);
            SORT16_DESC(top);
#pragma unroll 1
            for (int blk = 1; blk < 8; ++blk) {
                unsigned v[16];
#pragma unroll
                for (int i = 0; i < 16; ++i) v[i] = (fkey(lp[blk * 16 + i]) & ~127u) | (unsigned)(127 - (blk * 16 + i));
                SORT16_DESC(v);
#pragma unroll
                for (int i = 0; i < 16; ++i) top[i] = max(top[i], v[15 - i]);
#pragma unroll
                for (int j = 8; j > 0; j >>= 1)
#pragma unroll
                    for (int i = 0; i < 16; ++i) { const int l = i ^ j; if (l > i) CE_DESC(top[i], top[l]); }
            }
#ifdef SELFCHECK2
            { unsigned ref[16];
#pragma unroll
              for (int s2 = 0; s2 < 16; ++s2) ref[s2] = 0u;
#pragma unroll 4
              for (int n = 0; n < 128; ++n) { const unsigned key = (fkey(lp[n]) & ~127u) | (unsigned)(127 - n); TOPK_INSERT(ref, key); }
              bool badk = false;
#pragma unroll
              for (int s2 = 0; s2 < 16; ++s2) badk |= (ref[s2] != top[s2]);
              if (badk) p.out[O_CV + 1] = __builtin_nanf(""); }
#endif
#undef CE_DESC
#undef CE_ASC
#undef SORT16_DESC
#pragma unroll
            for (int s = 0; s < 16; ++s) tl[tid * 16 + s] = top[s];
        }
        __syncthreads();
        if (tid < 128 && (b0 + (tid >> 3)) < ntok) {
            const unsigned* la = tl + (tid * 2) * 16; const unsigned* lb = la + 16;
            float av[16], bv[16];
#pragma unroll
            for (int s = 0; s < 16; ++s) { av[s] = kval(la[s] & ~127u); bv[s] = kval(lb[s] & ~127u); }
            unsigned top[16];
#define KEY2(i, j) ((fkey(av[i] + bv[j]) & ~255u) | (unsigned)(255 - ((i) * 16 + (j))))
#define CE_DESC(a, b) do { const unsigned _hi = max(a, b), _lo = min(a, b); a = _hi; b = _lo; } while (0)
#define MERGE16(t) do { _Pragma("unroll") for (int _j = 8; _j > 0; _j >>= 1) _Pragma("unroll") for (int _i = 0; _i < 16; ++_i) { const int _l = _i ^ _j; if (_l > _i) CE_DESC(t[_i], t[_l]); } } while (0)
#pragma unroll
            for (int j = 0; j < 16; ++j) top[j] = KEY2(0, j);
#pragma unroll
            for (int r = 1; r < 8; ++r) { const int m = 16 / (r + 1);
#pragma unroll
                for (int q = 0; q < 8; ++q) if (q < m) top[15 - q] = max(top[15 - q], KEY2(r, q));
                MERGE16(top); }
#pragma unroll
            for (int q = 0; q < 8; ++q) top[15 - q] = max(top[15 - q], KEY2(8 + q, 0));
            MERGE16(top);
#ifdef SELFCHECK2
            { unsigned ref[16];
#pragma unroll
              for (int s2 = 0; s2 < 16; ++s2) ref[s2] = 0u;
#pragma unroll
              for (int i = 0; i < 16; ++i)
#pragma unroll
                  for (int j = 0; j < 16; ++j)
                      if ((i + 1) * (j + 1) <= 16) { const unsigned key = KEY2(i, j); TOPK_INSERT(ref, key); }
              bool badk = false;
#pragma unroll
              for (int s2 = 0; s2 < 16; ++s2) badk |= (ref[s2] != top[s2]);
              if (badk) p.out[O_CV + 2] = __builtin_nanf(""); }
#endif
#undef KEY2
#undef CE_DESC
#undef MERGE16
            const float smax = kval(top[0] & ~255u); float e[16]; float es = 0.f;
#pragma unroll
            for (int s = 0; s < 16; ++s) { e[s] = __expf(kval(top[s] & ~255u) - smax); es += e[s]; }
            const float inv = 1.f / es;
            const int t = tbase + b0 + (tid >> 3), hh = tid & 7;
#pragma unroll
            for (int s = 0; s < 16; ++s) { const int pos = 255 - (int)(top[s] & 255u); const int i = pos >> 4, j = pos & 15;
                const int n1 = 127 - (int)(la[i] & 127u), n2 = 127 - (int)(lb[j] & 127u);
                SELI[(size_t)t * 128 + hh * 16 + s] = n1 * 128 + n2; SELG[(size_t)t * 128 + hh * 16 + s] = e[s] * inv; }
        }
    }
#endif
    xcd_barrier(xbar);
#ifndef PEER_NO_GATHER
    const unsigned char* U8 = p.ws + WS_U8; const unsigned char* V8 = U8 + (size_t)16384 * ROW4;
    const int sA = ((lane >> 2) & 15) * 4 + ((lane & 1) << 1) + ((lane >> 1) & 1);
    unsigned* wsl = (unsigned*)smem + wid * 1536;
    u32x4 b0[4], b1[4], b2[4], b3[4];
#define PEER_LN(g, j) ((((g) & 15) << 2) | (((j) & 1) << 1) | (((j) >> 1) & 1))
#define PEER_LOADS(buf, s_) do { const int _s = (s_); const int _g = _s & 31; const unsigned char* _tab = _s < 32 ? U8 : V8; const int _ir = _g < 16 ? idx0 : idx1; \
            _Pragma("unroll") for (int _j = 0; _j < 4; ++_j) { const int _idx = __builtin_amdgcn_readlane(_ir, PEER_LN(_g, _j)); buf[_j] = *(const u32x4*)(_tab + (size_t)_idx * ROW4 + lane * 16); } \
            __builtin_amdgcn_sched_barrier(0); } while (0)
#define PEER_DOTG(buf, g) do { float d[4]; _Pragma("unroll") for (int _j = 0; _j < 4; ++_j) { const u32x4 w = buf[_j]; f32x2 a2 = {0.f, 0.f}; \
            _Pragma("unroll") for (int qd = 0; qd < 4; ++qd) { \
                a2 += __builtin_amdgcn_cvt_scalef32_pk_f32_fp4(w[qd], 1.0f, 0) * (f32x2){hx[qd * 8 + 0], hx[qd * 8 + 1]}; a2 += __builtin_amdgcn_cvt_scalef32_pk_f32_fp4(w[qd], 1.0f, 1) * (f32x2){hx[qd * 8 + 2], hx[qd * 8 + 3]}; \
                a2 += __builtin_amdgcn_cvt_scalef32_pk_f32_fp4(w[qd], 1.0f, 2) * (f32x2){hx[qd * 8 + 4], hx[qd * 8 + 5]}; a2 += __builtin_amdgcn_cvt_scalef32_pk_f32_fp4(w[qd], 1.0f, 3) * (f32x2){hx[qd * 8 + 6], hx[qd * 8 + 7]}; } \
            d[_j] = a2.x + a2.y; } \
          const bool u1 = (lane & 1) != 0; \
          const float s0 = u1 ? d[0] : d[2], k0 = u1 ? d[2] : d[0], s1 = u1 ? d[1] : d[3], k1 = u1 ? d[3] : d[1]; \
          const float e0 = k0 + __shfl_xor(s0, 1), e1 = k1 + __shfl_xor(s1, 1); \
          const bool u2 = (lane & 2) != 0; const float s2 = u2 ? e0 : e1, k2 = u2 ? e1 : e0; \
          float f = k2 + __shfl_xor(s2, 2); f += __shfl_xor(f, 4); f += __shfl_xor(f, 8); f += __shfl_xor(f, 16); f += __shfl_xor(f, 32); \
          if (((lane >> 2) & 15) == ((g) & 15)) { if ((g) < 16) dot0 = f; else dot1 = f; } } while (0)
#define PEER_ACCG(buf, g) do { const float _wr = (g) < 16 ? wt0 : wt1; _Pragma("unroll") for (int _j = 0; _j < 4; ++_j) { \
            const float wk = __uint_as_float(__builtin_amdgcn_readlane(__float_as_uint(_wr), PEER_LN(g, _j))); const f32x2 wk2 = {wk, wk}; const u32x4 w = buf[_j]; \
            _Pragma("unroll") for (int qd = 0; qd < 4; ++qd) { \
                acc[qd * 4 + 0] += wk2 * __builtin_amdgcn_cvt_scalef32_pk_f32_fp4(w[qd], 1.0f, 0); acc[qd * 4 + 1] += wk2 * __builtin_amdgcn_cvt_scalef32_pk_f32_fp4(w[qd], 1.0f, 1); \
                acc[qd * 4 + 2] += wk2 * __builtin_amdgcn_cvt_scalef32_pk_f32_fp4(w[qd], 1.0f, 2); acc[qd * 4 + 3] += wk2 * __builtin_amdgcn_cvt_scalef32_pk_f32_fp4(w[qd], 1.0f, 3); } } } while (0)
    { int k = 0;
      for (int ti = wid; ti < ntok; ti += 8, ++k) {
        const int t = tbase + ti;
        unsigned k0 = ((unsigned)SELI[(size_t)t * 128 + lane] << 7) | (unsigned)lane, k1 = ((unsigned)SELI[(size_t)t * 128 + 64 + lane] << 7) | (unsigned)(64 + lane);
#pragma unroll
        for (int kk = 2; kk <= 128; kk <<= 1) {
#pragma unroll
            for (int j = kk >> 1; j > 0; j >>= 1) {
                if (j == 64) { const unsigned lo = min(k0, k1), hi = max(k0, k1); k0 = lo; k1 = hi; }
                else { const unsigned p0 = __shfl_xor(k0, j), p1 = __shfl_xor(k1, j);
                    const bool lower = (lane & j) == 0;
                    const bool up0 = (kk == 128) ? true : ((lane & kk) == 0);
                    const bool up1 = (kk == 128) ? true : ((kk == 64) ? false : ((lane & kk) == 0));
                    k0 = (lower == up0) ? min(k0, p0) : max(k0, p0);
                    k1 = (lower == up1) ? min(k1, p1) : max(k1, p1); } } }
        const unsigned q0 = __shfl(k0, sA), q1 = __shfl(k1, sA);
        const int idx0 = (int)(q0 >> 7), idx1 = (int)(q1 >> 7);
        const float gt0 = SELG[(size_t)t * 128 + (q0 & 127u)], gt1 = SELG[(size_t)t * 128 + (q1 & 127u)];
        float hx[32];
#pragma unroll
        for (int q = 0; q < 8; ++q) { const u32x2 w = __builtin_nontemporal_load((const u32x2*)(H + (size_t)t * DM + q * 256 + lane * 4));
            hx[q * 4] = bf_lo(w.x); hx[q * 4 + 1] = bf_hi(w.x); hx[q * 4 + 2] = bf_lo(w.y); hx[q * 4 + 3] = bf_hi(w.y); }
        float dot0 = 0.f, dot1 = 0.f;
        PEER_LOADS(b0, 0); PEER_LOADS(b1, 1); PEER_LOADS(b2, 2);
#pragma unroll 1
        for (int sidx = 0; sidx < 32; sidx += 4) {
            if (sidx + 3 < 32) PEER_LOADS(b3, sidx + 3);
            PEER_DOTG(b0, sidx);
            if (sidx + 4 < 32) PEER_LOADS(b0, sidx + 4);
            PEER_DOTG(b1, sidx + 1);
            if (sidx + 5 < 32) PEER_LOADS(b1, sidx + 5);
            PEER_DOTG(b2, sidx + 2);
            if (sidx + 6 < 32) PEER_LOADS(b2, sidx + 6);
            PEER_DOTG(b3, sidx + 3);
        }
        dot0 *= (1.f / U_SCALE); dot1 *= (1.f / U_SCALE);
        const float wt0 = gt0 * 0.5f * dot0 * (1.f + erff(dot0 * 0.70710678118654752f)) * (1.f / V_SCALE);
        const float wt1 = gt1 * 0.5f * dot1 * (1.f + erff(dot1 * 0.70710678118654752f)) * (1.f / V_SCALE);
        wsl[(k * 4 + 0) * 64 + lane] = (unsigned)idx0; wsl[(k * 4 + 1) * 64 + lane] = (unsigned)idx1;
        wsl[(k * 4 + 2) * 64 + lane] = __float_as_uint(wt0); wsl[(k * 4 + 3) * 64 + lane] = __float_as_uint(wt1);
      } }
    { int k = 0;
      for (int ti = wid; ti < ntok; ti += 8, ++k) {
        const int t = tbase + ti;
        const int idx0 = (int)wsl[(k * 4 + 0) * 64 + lane], idx1 = (int)wsl[(k * 4 + 1) * 64 + lane];
        const float wt0 = __uint_as_float(wsl[(k * 4 + 2) * 64 + lane]), wt1 = __uint_as_float(wsl[(k * 4 + 3) * 64 + lane]);
        f32x2 acc[16];
#pragma unroll
        for (int i = 0; i < 16; ++i) acc[i] = (f32x2){0.f, 0.f};
        PEER_LOADS(b0, 32); PEER_LOADS(b1, 33); PEER_LOADS(b2, 34);
#pragma unroll 1
        for (int sidx = 32; sidx < 64; sidx += 4) {
            if (sidx + 3 < 64) PEER_LOADS(b3, sidx + 3);
            PEER_ACCG(b0, sidx - 32);
            if (sidx + 4 < 64) PEER_LOADS(b0, sidx + 4);
            PEER_ACCG(b1, sidx - 31);
            if (sidx + 5 < 64) PEER_LOADS(b1, sidx + 5);
            PEER_ACCG(b2, sidx - 30);
            if (sidx + 6 < 64) PEER_LOADS(b2, sidx + 6);
            PEER_ACCG(b3, sidx - 29);
        }
        const float* m = mod + (size_t)cond_of(t) * 12288 + 5 * 2048;
        const float2 st1 = *(const float2*)(p.ws + WS_STATS + (size_t)t * 8);
        float4 y[8]; float s1 = 0.f, s2 = 0.f;
#pragma unroll
        for (int q = 0; q < 8; ++q) { const int col = q * 256 + lane * 4;
            const float4 g2 = *(const float4*)(m + col); const u32x2 y1w = __builtin_nontemporal_load((const u32x2*)(X1 + (size_t)t * DM + col)); const f32x4 y1v = {bf_lo(y1w.x), bf_hi(y1w.x), bf_lo(y1w.y), bf_hi(y1w.y)}; const float4 l1g = *(const float4*)(p.ln1_g + col), l1b = *(const float4*)(p.ln1_b + col);
            const float4 x1 = {(y1v[0] - st1.x) * st1.y * l1g.x + l1b.x, (y1v[1] - st1.x) * st1.y * l1g.y + l1b.y, (y1v[2] - st1.x) * st1.y * l1g.z + l1b.z, (y1v[3] - st1.x) * st1.y * l1g.w + l1b.w};
            y[q].x = DN_ALPHA * x1.x + g2.x * acc[q * 2].x; y[q].y = DN_ALPHA * x1.y + g2.y * acc[q * 2].y; y[q].z = DN_ALPHA * x1.z + g2.z * acc[q * 2 + 1].x; y[q].w = DN_ALPHA * x1.w + g2.w * acc[q * 2 + 1].y;
            s1 += (y[q].x + y[q].y) + (y[q].z + y[q].w); }
        const float mu = wave_sum(s1) * (1.f / 2048.f);
#pragma unroll
        for (int q = 0; q < 8; ++q) { const float a = y[q].x - mu, b = y[q].y - mu, c = y[q].z - mu, d = y[q].w - mu; s2 += (a * a + b * b) + (c * c + d * d); }
        const float rs = rsqrtf(wave_sum(s2) * (1.f / 2048.f) + EPS);
#pragma unroll
        for (int q = 0; q < 8; ++q) { const int col = q * 256 + lane * 4;
            const float4 lg = *(const float4*)(p.ln2_g + col), lb = *(const float4*)(p.ln2_b + col);
            float4 o; o.x = (y[q].x - mu) * rs * lg.x + lb.x; o.y = (y[q].y - mu) * rs * lg.y + lb.y; o.z = (y[q].z - mu) * rs * lg.z + lb.z; o.w = (y[q].w - mu) * rs * lg.w + lb.w;
            __builtin_nontemporal_store((f32x4){o.x, o.y, o.z, o.w}, (f32x4*)(p.out + O_Y + (size_t)t * DM + col)); }
      } }
#undef PEER_LN
#undef PEER_LOADS
#undef PEER_DOTG
#undef PEER_ACCG
#endif
}


#ifdef SELFCHECK
__device__ __forceinline__ void phase_selfcheck(const Params& p, unsigned char* smem) {
    const int lane = threadIdx.x & 63, wid = threadIdx.x >> 6; const int gw = blockIdx.x * 8 + wid;
    const bf16_t* P = (const bf16_t*)(p.ws + WS_A); const bf16_t* MIX = (const bf16_t*)(p.ws + WS_E);
    const bf16_t* KC = (const bf16_t*)(p.ws + WS_KC); const bf16_t* VC = (const bf16_t*)(p.ws + WS_VC);
    const bf16_t* KL = (const bf16_t*)(p.ws + WS_KL); const bf16_t* VL = (const bf16_t*)(p.ws + WS_VL);
    float* pl = (float*)smem + wid * 4352;
    const int t = (int)(((unsigned)gw * 2654435761u) % (unsigned)TT); const int h = gw & 7; const int kvh = h >> 2;
    const bool lat = t >= TP; const int tl = lat ? t - TP : t;
    const int b = lat ? (tl >> 12) : (tl >> 8); const int S = lat ? SKV_L : 256;
    const bf16_t* Kb = lat ? KL + (size_t)(b * 2 + kvh) * SKV_L * 128 : KC + (size_t)(b * 2 + kvh) * 256 * 128;
    const bf16_t* Vb = lat ? VL + (size_t)(b * 2 + kvh) * SKV_L * 128 : VC + (size_t)(b * 2 + kvh) * 256 * 128;
    bool bad = false;
    { const bf16_t* raw = P + (size_t)t * NCOL + C_KA + kvh * 128;
      float ss = 0.f; for (int d = 0; d < 128; ++d) { const float x = bf2f(raw[d]); ss += x * x; }
      const float r = 1.f / sqrtf(ss / 128.f + EPS);
      for (int d = lane; d < 128; d += 64) {
          const float y = bf2f(raw[d]) * r * p.kn_g[d];
          float o = y;
          if (lat) { const int l = tl & 4095; const int row = l / 64, col = l % 64;
              const int sec = d / 32, fi = d % 32; const float invf = powf(10000.f, -(float)(2 * fi) / 64.f);
              const float ang = (float)(sec < 2 ? row : col) * invf;
              const int dp = (sec & 1) ? d - 32 : d + 32; const float yp = bf2f(raw[dp]) * r * p.kn_g[dp];
              o = (sec & 1) ? y * cosf(ang) + yp * sinf(ang) : y * cosf(ang) - yp * sinf(ang); }
          const float got = bf2f(Kb[(size_t)(lat ? 256 + (tl & 4095) : (tl & 255)) * 128 + d]);
          if (!(fabsf(got - o) <= 0.02f * fabsf(o) + 0.02f)) bad = true; } }
    { const bf16_t* q = P + (size_t)t * NCOL + C_QA + h * 128;
      float mx = -1e30f;
      for (int j = lane; j < S; j += 64) { float sc = 0.f; for (int d = 0; d < 128; ++d) sc += bf2f(q[d]) * bf2f(Kb[(size_t)j * 128 + d]); sc *= 0.08838834764831845f; pl[j] = sc; mx = fmaxf(mx, sc); }
      for (int o = 32; o; o >>= 1) mx = fmaxf(mx, __shfl_xor(mx, o));
      float sum = 0.f;
      for (int j = lane; j < S; j += 64) { const float e = expf(pl[j] - mx); pl[j] = e; sum += e; }
      sum = wave_sum(sum);
      __builtin_amdgcn_s_waitcnt(0);
      for (int d = lane; d < 128; d += 64) { float o = 0.f; for (int j = 0; j < S; ++j) o += pl[j] * bf2f(Vb[(size_t)j * 128 + d]); o /= sum;
          const float got = bf2f(MIX[(size_t)t * DM + 1024 + h * 128 + d]);
          if (!(fabsf(got - o) <= 0.03f * fabsf(o) + 0.004f)) bad = true; } }
    if (bad) p.out[O_CV] = __builtin_nanf("");
}
#endif

__global__ void __launch_bounds__(NTHREADS, 2) fwd_megakernel(Params p) {
    extern __shared__ __attribute__((aligned(16))) unsigned char smem[];
    cg::grid_group grid = cg::this_grid();
    const int lo = p.ph_lo, hi = p.ph_hi;
#ifndef PHM
#define PHM 0x3ff
#endif
#define IN(k) (((PHM >> (k)) & 1) && lo <= (k) && (k) < hi)
    unsigned nbar = 0; unsigned* barw = (unsigned*)(p.ws + WS_BAR);
    { LAS unsigned* stw = (LAS unsigned*)((LAS unsigned char*)smem + (LDS_BYTES - 16)); if (threadIdx.x == 0) { stw[0] = 0u; stw[1] = 0u; } }
    __syncthreads();
    XcdBarrier xbar = xcd_barrier_post((unsigned*)(p.ws + WS_BAR), (volatile LAS unsigned*)((LAS unsigned char*)smem + (LDS_BYTES - 16)));
    if (p.ph_lo < 0) grid.sync();
#define SEAM(k) do { if (IN(k) && IN((k) + 1)) xcd_barrier(xbar); } while (0)
    if (IN(0)) phase_prep(p, smem);
    SEAM(0);
    if (IN(1)) phase_h1(p);
    SEAM(1);
    if (IN(2)) { pg8::Gemm g{(const bf16_t*)(p.ws + WS_H), (const bf16_t*)(p.ws + WS_WTIN), TT, NCOL, DM}; pg8::StaticOrder S; S.init(TT, NCOL, gridDim.x, blockIdx.x);
        pg8::EpiBf16 E{(bf16_t*)(p.ws + WS_A), NCOL}; pg8::gemm_phase(( LAS unsigned char*)smem, g, S, E);
        { const int G = gridDim.x, rem = ((TT / 256) * (NCOL / 256)) % G; const int first = rem, nb = G - rem;
          if ((int)blockIdx.x >= first) { const size_t gt = (size_t)(blockIdx.x - first) * NTHREADS + threadIdx.x, gn = (size_t)nb * NTHREADS;
              cvt_fp4_table(p.peer_u, p.ws + WS_U8, U_SCALE, gt, gn); } } }
    SEAM(2);
    if (IN(3)) { phase_postproj(p); phase_chunk_kv(p, smem); }
    SEAM(3);
    if (IN(4)) { phase_scan(p); phase_attention(p, smem); }
    SEAM(4);
    if (IN(5)) {
#ifdef SELFCHECK
        phase_selfcheck(p, smem); __syncthreads();
#endif
        phase_ret_out(p, smem); }
    SEAM(5);
    if (IN(6)) { pg8::Gemm g{(const bf16_t*)(p.ws + WS_E), (const bf16_t*)(p.ws + WS_WTO), TT, DM, DM}; pg8::StaticOrder S; S.init(TT, DM, gridDim.x, blockIdx.x);
        pg8::EpiY1 E{(bf16_t*)(p.ws + WS_B), p.x_prompt, p.x_sample, (const float*)(p.ws + WS_MOD)}; pg8::gemm_phase((LAS unsigned char*)smem, g, S, E);
        { const int G = gridDim.x, rem = ((TT / 256) * (DM / 256)) % G; const int first = rem, nb = G - rem;
          if ((int)blockIdx.x >= first) { const size_t gt = (size_t)(blockIdx.x - first) * NTHREADS + threadIdx.x, gn = (size_t)nb * NTHREADS;
              cvt_fp4_table(p.peer_v, p.ws + WS_U8 + (size_t)16384 * ROW4, V_SCALE, gt, gn); } } }
    SEAM(6);
    if (IN(7)) phase_ln1(p);
    SEAM(7);
    if (IN(8)) { pg8::Gemm g{(const bf16_t*)(p.ws + WS_H), (const bf16_t*)(p.ws + WS_WTQ), TT, DM, DM}; pg8::StaticOrder S; S.init(TT, DM, gridDim.x, blockIdx.x);
        pg8::EpiBf16 E{(bf16_t*)(p.ws + WS_D), DM}; pg8::gemm_phase((LAS unsigned char*)smem, g, S, E); }
    SEAM(8);
#ifndef REP9
#define REP9 1
#endif
    if (IN(9)) phase_peer(p, smem, xbar);
#undef IN
#undef SEAM
}

#ifndef MK_MULTI
#define MK_MULTI 0
#endif
extern "C" void kernel_launch(void* const* d_in, const int* in_sizes, int n_in, void* d_out, int out_size, void* d_ws, size_t ws_size, hipStream_t stream) {
    static int grid = 0;
    if (grid == 0) {
        if (n_in != 23 || ws_size < WS_END) { fprintf(stderr, "kernel_launch: n_in %d ws %zu (need %zu)\n", n_in, ws_size, (size_t)WS_END); grid = -1; return; }
        if (hipFuncSetAttribute((const void*)fwd_megakernel, hipFuncAttributeMaxDynamicSharedMemorySize, LDS_BYTES) != hipSuccess) { fprintf(stderr, "kernel_launch: hipFuncSetAttribute failed\n"); grid = -1; return; }
        int dev = 0, cus = 0, per_cu = 0;
        hipGetDevice(&dev); hipDeviceGetAttribute(&cus, hipDeviceAttributeMultiprocessorCount, dev);
        hipOccupancyMaxActiveBlocksPerMultiprocessor(&per_cu, (const void*)fwd_megakernel, NTHREADS, LDS_BYTES);
        if (per_cu < 1) { fprintf(stderr, "kernel_launch: occupancy query says %d blocks/CU\n", per_cu); per_cu = 1; }
        grid = cus;
        if (grid > 256) grid = 256;
        if (TT % grid != 0) { fprintf(stderr, "kernel_launch: grid %d does not divide %d tokens\n", grid, TT); grid = -1; return; }
    }
    if (grid < 0) return;
    (void)hipMemsetAsync((char*)d_ws + WS_MOD, 0, 3 * 12288 * 4 + XCD_BAR_WORDS * 4, stream);
    Params p{};
    p.x_prompt = (const float*)d_in[0]; p.x_sample = (const float*)d_in[1]; p.state_ret = (const float*)d_in[2]; p.cache_k = (const float*)d_in[3]; p.cache_v = (const float*)d_in[4];
    p.c = (const float*)d_in[5]; p.c_ctx = (const float*)d_in[6]; p.w_ada = (const float*)d_in[7]; p.b_ada = (const float*)d_in[8]; p.w_in = (const float*)d_in[9]; p.decay = (const float*)d_in[10];
    p.gn_g = (const float*)d_in[11]; p.qn_g = (const float*)d_in[12]; p.kn_g = (const float*)d_in[13]; p.w_o = (const float*)d_in[14]; p.ln1_g = (const float*)d_in[15]; p.ln1_b = (const float*)d_in[16];
    p.w_q = (const float*)d_in[17]; p.sub_keys = (const float*)d_in[18]; p.peer_u = (const float*)d_in[19]; p.peer_v = (const float*)d_in[20]; p.ln2_g = (const float*)d_in[21]; p.ln2_b = (const float*)d_in[22];
    p.out = (float*)d_out; p.ws = (unsigned char*)d_ws;
    for (int i = 0; i < 10; ++i) p.rep[i] = 1;
#ifdef REPX
    p.rep[REPX] = 2;
#endif
#if MK_MULTI
    for (int ph = 0; ph < 10; ++ph) { p.ph_lo = ph; p.ph_hi = ph + 1; hipLaunchKernelGGL(fwd_megakernel, dim3(grid), dim3(NTHREADS), LDS_BYTES, stream, p); }
#else
    p.ph_lo = 0; p.ph_hi = 10;
    void* args[] = {&p};
    hipError_t e = hipLaunchCooperativeKernel((const void*)fwd_megakernel, dim3(grid), dim3(NTHREADS), args, LDS_BYTES, stream);
    if (e != hipSuccess) fprintf(stderr, "kernel_launch: cooperative launch failed: %s (grid %d)\n", hipGetErrorString(e), grid);
#endif
}
```

```cpp
#include <hip/hip_runtime.h>
#include <hip/hip_cooperative_groups.h>
#include <cstdio>
#include <cstdint>
namespace cg = cooperative_groups;

#define LAS __attribute__((address_space(3)))
typedef unsigned short bf16_t;
typedef short bf16x8 __attribute__((ext_vector_type(8)));
typedef short s16x4 __attribute__((ext_vector_type(4)));
typedef float f32x4 __attribute__((ext_vector_type(4)));
typedef float f32x2 __attribute__((ext_vector_type(2)));
typedef float f32x16 __attribute__((ext_vector_type(16)));
typedef unsigned u32x4 __attribute__((ext_vector_type(4)));
typedef unsigned u32x2 __attribute__((ext_vector_type(2)));
typedef unsigned u32x6 __attribute__((ext_vector_type(6)));
typedef float f32x32 __attribute__((ext_vector_type(32)));

constexpr int DM = 2048;
constexpr int TP = 4096;
constexpr int TS = 8192;
constexpr int TT = TP + TS;
constexpr int NCOL = 5632;
constexpr int C_QR = 0, C_KR = 1024, C_VR = 2048, C_GR = 3072, C_QA = 4096, C_KA = 5120, C_VA = 5376;
constexpr int SKV_L = 4352;
constexpr float EPS = 1e-5f;
constexpr float DN_ALPHA = 1.189207115002721f;
constexpr int NTHREADS = 512;
constexpr int LDS_BYTES = 155648;

constexpr size_t O_Y = 0;
constexpr size_t O_STATE = (size_t)TT * DM;
constexpr size_t O_CK = O_STATE + 16ull * 2 * 8 * 16384;
constexpr size_t O_CV = O_CK + 16ull * 256 * 2 * 128;

constexpr size_t WS_MOD  = 0;
constexpr size_t WS_WTIN = 1ull << 20;
constexpr size_t WS_WTO  = WS_WTIN + (size_t)NCOL * DM * 2;
constexpr size_t WS_WTQ  = WS_WTO + (size_t)DM * DM * 2;
constexpr size_t WS_KEYS = WS_WTQ + (size_t)DM * DM * 2;
constexpr size_t WS_KC   = WS_KEYS + 262144ull * 2;
constexpr size_t WS_VC   = WS_KC + 16ull * 2 * 256 * 128 * 2;
constexpr size_t WS_KL   = WS_VC + 16ull * 2 * 256 * 128 * 2;
constexpr size_t WS_VL   = WS_KL + 2ull * 2 * SKV_L * 128 * 2;
constexpr size_t WS_SEL  = WS_VL + 2ull * 2 * SKV_L * 128 * 2;
constexpr size_t WS_H    = WS_SEL + (size_t)TT * 128 * 8;
constexpr size_t WS_A    = WS_H + (size_t)TT * DM * 2;
constexpr size_t WS_B    = WS_A + (size_t)TT * NCOL * 2;
constexpr size_t WS_D    = WS_B + (size_t)TT * DM * 4;
constexpr size_t WS_E    = WS_D + (size_t)TT * DM * 2;
constexpr size_t WS_U8   = WS_E + (size_t)TT * DM * 2;
constexpr size_t WS_END  = WS_U8 + 2ull * 16384 * 2048;
constexpr size_t WS_STATS = 512ull << 10;
static_assert(768ull * 2 * 16384 * 4 <= (size_t)TT * DM * 4, "KVC fits region B");
static_assert(768ull * 2 * 16384 * 2 <= (size_t)TT * DM * 2, "SPREV fits region D");

struct Params {
    const float* x_prompt; const float* x_sample; const float* state_ret; const float* cache_k; const float* cache_v;
    const float* c; const float* c_ctx; const float* w_ada; const float* b_ada; const float* w_in; const float* decay;
    const float* gn_g; const float* qn_g; const float* kn_g; const float* w_o; const float* ln1_g; const float* ln1_b;
    const float* w_q; const float* sub_keys; const float* peer_u; const float* peer_v; const float* ln2_g; const float* ln2_b;
    float* out; unsigned char* ws; int ph_lo, ph_hi; int rep[10]; int pad0, pad1;
};

__device__ __forceinline__ unsigned cvt_pk_bf16(float lo, float hi) { unsigned r; asm volatile("v_cvt_pk_bf16_f32 %0, %1, %2" : "=v"(r) : "v"(lo), "v"(hi)); return r; }
__device__ __forceinline__ bf16_t f2bf(float x) { return (bf16_t)(cvt_pk_bf16(x, 0.f) & 0xffffu); }
__device__ __forceinline__ float bf2f(bf16_t b) { return __uint_as_float(((unsigned)b) << 16); }
__device__ __forceinline__ float bf_lo(unsigned w) { return __uint_as_float(w << 16); }
__device__ __forceinline__ float bf_hi(unsigned w) { return __uint_as_float(w & 0xffff0000u); }
__device__ __forceinline__ float wave_sum(float v) {
#pragma unroll
    for (int o = 32; o; o >>= 1) v += __shfl_xor(v, o);
    return v;
}
__device__ __forceinline__ float log_sigmoid(float x) { return fminf(x, 0.f) - log1pf(__expf(-fabsf(x))); }
__device__ __forceinline__ float silu_f(float x) { return x / (1.f + __expf(-x)); }
__device__ __forceinline__ const float* x_row(const Params& p, int t) { return t < TP ? p.x_prompt + (size_t)t * DM : p.x_sample + (size_t)(t - TP) * DM; }
__device__ __forceinline__ int cond_of(int t) { return t < TP ? 0 : 1 + ((t - TP) >> 12); }

namespace pg8 {
constexpr int BM = 256, BK = 64, HALF = 128, HTB = HALF * BK * 2, STAGE_BYTES = 8 * HTB, NXCD = 8, WGM = 8;
__host__ __device__ __forceinline__ int lds_byte(int r, int c) { const int st = (r >> 4) * 2 + (c >> 5), rr = r & 15, cc = c & 31, ob = rr * 64 + cc * 2; return st * 1024 + (ob ^ (((ob >> 9) & 1) << 5)); }
__host__ __device__ __forceinline__ void stage_rc(int b, int& R, int& C) { const int st = b / 1024, sb = b % 1024, swz = sb ^ (((sb >> 9) & 1) << 5); R = (st >> 1) * 16 + swz / 64; C = (st & 1) * 32 + (swz % 64) / 2; }
__host__ __device__ __forceinline__ int perm32(int rho) { const int n = rho >> 4, i = rho & 15; return 8 * (i >> 2) + 4 * n + (i & 3); }
struct Unit { int pm, pn; };
struct Gemm { const bf16_t* A; const bf16_t* Bt; int M, N, K; };
struct StaticOrder {
    int nM, nN, nwg, G, c;
    __device__ void init(int M, int N, int G_, int c_) { nM = M / BM; nN = N / BM; nwg = nM * nN; G = G_; c = c_; }
    __device__ bool next(int i, Unit& u) const {
        const long L = (long)i * G + c; if (L >= nwg) return false;
        int wgid = (int)L; { const int q = nwg / NXCD, r = nwg % NXCD, xcd = wgid % NXCD, off = wgid / NXCD; wgid = (xcd < r ? xcd * (q + 1) : r * (q + 1) + (xcd - r) * q) + off; }
        const int nig = WGM * nN, gid = wgid / nig, fm = gid * WGM, gsz = (nM - fm) < WGM ? (nM - fm) : WGM;
        u.pm = fm + ((wgid % nig) % gsz); u.pn = (wgid % nig) / gsz; return true;
    }
    __device__ __forceinline__ void a_ready(const Unit&) const {}
    __device__ __forceinline__ void done(const Unit&) const {}
};
struct EpiBf16 {
    static constexpr bool PERM = true;
    bf16_t* O; int ldc;
    __device__ __forceinline__ void operator()(const f32x4 (&acc)[2][2][4][2], const Unit& u, int wr, int wc, int fr, int fq) const {
        const int row0 = u.pm * BM + wr * 64 + fr; const int col0 = u.pn * BM + wc * 32 + 8 * fq;
#pragma unroll
        for (int ai = 0; ai < 2; ++ai)
#pragma unroll
            for (int m = 0; m < 4; ++m) { bf16_t* rowp = O + (size_t)(row0 + ai * HALF + m * 16) * ldc + col0;
#pragma unroll
                for (int bj = 0; bj < 2; ++bj) { const f32x4 v0 = acc[ai][bj][m][0], v1 = acc[ai][bj][m][1];
                    u32x4 w; w.x = cvt_pk_bf16(v0[0], v0[1]); w.y = cvt_pk_bf16(v0[2], v0[3]); w.z = cvt_pk_bf16(v1[0], v1[1]); w.w = cvt_pk_bf16(v1[2], v1[3]);
                    *(u32x4*)(rowp + bj * HALF) = w; } }
    }
};
struct EpiY1 {
    static constexpr bool PERM = true;
    bf16_t* Y; const float* xp; const float* xs; const float* mod;
    __device__ __forceinline__ void operator()(const f32x4 (&acc)[2][2][4][2], const Unit& u, int wr, int wc, int fr, int fq) const {
        const int row0 = u.pm * BM + wr * 64 + fr, col0 = u.pn * BM + wc * 32 + 8 * fq;
        const int cnd = (u.pm * BM) < TP ? 0 : 1 + ((u.pm * BM - TP) >> 12);
        const float* g1 = mod + (size_t)cnd * 12288 + 2 * 2048;
        f32x4 gv[2][2];
#pragma unroll
        for (int bj = 0; bj < 2; ++bj)
#pragma unroll
            for (int n = 0; n < 2; ++n) gv[bj][n] = *(const f32x4*)(g1 + col0 + bj * HALF + n * 4);
#pragma unroll
        for (int ai = 0; ai < 2; ++ai)
#pragma unroll
            for (int m = 0; m < 4; ++m) { const int row = row0 + ai * HALF + m * 16;
                const float* xr = (row < TP ? xp + (size_t)row * DM : xs + (size_t)(row - TP) * DM) + col0;
                bf16_t* yr = Y + (size_t)row * DM + col0;
#pragma unroll
                for (int bj = 0; bj < 2; ++bj) { const f32x4 x0 = __builtin_nontemporal_load((const f32x4*)(xr + bj * HALF)), x1 = __builtin_nontemporal_load((const f32x4*)(xr + bj * HALF + 4));
                    const f32x4 v0 = x0 * DN_ALPHA + gv[bj][0] * acc[ai][bj][m][0], v1 = x1 * DN_ALPHA + gv[bj][1] * acc[ai][bj][m][1];
                    u32x4 w; w.x = cvt_pk_bf16(v0[0], v0[1]); w.y = cvt_pk_bf16(v0[2], v0[3]); w.z = cvt_pk_bf16(v1[0], v1[1]); w.w = cvt_pk_bf16(v1[2], v1[3]);
                    *(u32x4*)(yr + bj * HALF) = w; } }
    }
};

template <class Epi, class Sched>
__device__ __forceinline__ void gemm_phase(LAS unsigned char* lds, const Gemm g, const Sched& S, const Epi& E) {
    const int tid = threadIdx.x, wid = __builtin_amdgcn_readfirstlane(tid >> 6), lane = tid & 63, wr = wid >> 2, wc = wid & 3, fr = lane & 15, fq = lane >> 4;
    const int K = g.K, nt = K / BK;
    unsigned voffA[2], voffB[2];
#pragma unroll
    for (int i = 0; i < 2; ++i) { int R, C; stage_rc(tid * 16 + i * 8192, R, C); const int Rb = Epi::PERM ? ((R & ~31) + perm32(R & 31)) : R;
        voffA[i] = (unsigned)(R * K + C) * 2u; voffB[i] = (unsigned)(Rb * K + C) * 2u; }
    const size_t kstep = (size_t)(BK * 2);
    const size_t hstep = (size_t)HALF * K * 2;
    const size_t tstep = 2 * hstep;
    const unsigned ldsw = (unsigned)wid * 1024u;
    const int aoff = lds_byte(wr * 64 + fr, fq * 8), boff = lds_byte(wc * 32 + fr, fq * 8);
#define PG8_SA(b, h) (((b) * 2 + (h)) * HTB)
#define PG8_SB(b, h) ((4 + (b) * 2 + (h)) * HTB)
#define PG8_STAGE(bufoff, gbase, voff) do { _Pragma("unroll") for (int _i = 0; _i < 2; ++_i) \
        __builtin_amdgcn_global_load_lds((const unsigned*)((const char*)(gbase) + (voff)[_i]), (LAS unsigned*)(lds + (bufoff) + ldsw + _i * 8192), 16, 0, 0); } while (0)
#define PG8_LDA(dst, b, h) do { _Pragma("unroll") for (int m = 0; m < 4; ++m) _Pragma("unroll") for (int k = 0; k < 2; ++k) dst[m][k] = *(const LAS bf16x8*)(lds + PG8_SA(b, h) + aoff + m * 2048 + k * 1024); } while (0)
#define PG8_LDB(dst, b, h) do { _Pragma("unroll") for (int n = 0; n < 2; ++n) _Pragma("unroll") for (int k = 0; k < 2; ++k) dst[n][k] = *(const LAS bf16x8*)(lds + PG8_SB(b, h) + boff + n * 2048 + k * 1024); } while (0)
#define PG8_MMA(ai, bj, At, Bt) do { __builtin_amdgcn_s_setprio(1); _Pragma("unroll") for (int m = 0; m < 4; ++m) _Pragma("unroll") for (int n = 0; n < 2; ++n) _Pragma("unroll") for (int k = 0; k < 2; ++k) \
        acc[ai][bj][m][n] = __builtin_amdgcn_mfma_f32_16x16x32_bf16(Bt[n][k], At[m][k], acc[ai][bj][m][n], 0, 0, 0); __builtin_amdgcn_s_setprio(0); } while (0)
#define PG8_WAIT_V(n) asm volatile("s_waitcnt vmcnt(" #n ")" ::: "memory")
#define PG8_WAIT_L(n) asm volatile("s_waitcnt lgkmcnt(" #n ")" ::: "memory")
#define PG8_BAR __builtin_amdgcn_s_barrier()
#define PG8_SCHED __builtin_amdgcn_sched_barrier(0)
    Unit cur, nxt; int ui = 0;
    if (!S.next(0, cur)) return;
    f32x4 acc[2][2][4][2];
#pragma unroll
    for (int a = 0; a < 2; ++a)
#pragma unroll
        for (int b = 0; b < 2; ++b)
#pragma unroll
            for (int m = 0; m < 4; ++m)
#pragma unroll
                for (int n = 0; n < 2; ++n) acc[a][b][m][n] = (f32x4){0.f, 0.f, 0.f, 0.f};
    bf16x8 At[4][2], B0[2][2], B1[2][2];
    const char* cA = (const char*)g.A + (size_t)cur.pm * tstep; const char* cB = (const char*)g.Bt + (size_t)cur.pn * tstep;
    S.a_ready(cur);
    PG8_STAGE(PG8_SB(0, 0), cB, voffB); PG8_STAGE(PG8_SA(0, 0), cA, voffA); PG8_STAGE(PG8_SB(0, 1), cB + hstep, voffB); PG8_STAGE(PG8_SA(0, 1), cA + hstep, voffA);
    if (wr == 1) PG8_BAR;
    PG8_WAIT_V(4); PG8_BAR;
    PG8_STAGE(PG8_SB(1, 0), cB + kstep, voffB); PG8_STAGE(PG8_SA(1, 0), cA + kstep, voffA); PG8_STAGE(PG8_SB(1, 1), cB + hstep + kstep, voffB);
    PG8_WAIT_V(6); PG8_BAR;
    for (;;) {
        const bool has_next = S.next(ui + 1, nxt);
        const char* nA = has_next ? (const char*)g.A + (size_t)nxt.pm * tstep : cA; const char* nB = has_next ? (const char*)g.Bt + (size_t)nxt.pn * tstep : cB;
        for (int t = 0; t < nt; t += 2) {
            const bool last = (t == nt - 2);
            const char* a1 = cA + (size_t)(t + 1) * kstep;
            const char* a2 = last ? nA : cA + (size_t)(t + 2) * kstep; const char* b2 = last ? nB : cB + (size_t)(t + 2) * kstep;
            const char* a3 = a2 + kstep; const char* b3 = b2 + kstep;
            if (last && has_next) S.a_ready(nxt);
            PG8_LDB(B0, 0, 0); PG8_SCHED; PG8_LDA(At, 0, 0); PG8_STAGE(PG8_SA(1, 1), a1 + hstep, voffA);
            PG8_WAIT_L(8); PG8_BAR; PG8_WAIT_L(0); PG8_MMA(0, 0, At, B0); PG8_BAR; PG8_SCHED;
            PG8_LDB(B1, 0, 1); PG8_STAGE(PG8_SB(0, 0), b2, voffB);
            PG8_BAR; PG8_WAIT_L(0); PG8_MMA(0, 1, At, B1); PG8_BAR;
            PG8_LDA(At, 0, 1); PG8_STAGE(PG8_SA(0, 0), a2, voffA);
            PG8_BAR; PG8_WAIT_L(0); PG8_MMA(1, 0, At, B0); PG8_BAR; PG8_SCHED;
            PG8_STAGE(PG8_SB(0, 1), b2 + hstep, voffB);
            PG8_WAIT_V(6); PG8_BAR; PG8_MMA(1, 1, At, B1); PG8_BAR;
            PG8_LDB(B0, 1, 0); PG8_SCHED; PG8_LDA(At, 1, 0); PG8_STAGE(PG8_SA(0, 1), a2 + hstep, voffA);
            PG8_WAIT_L(8); PG8_BAR; PG8_WAIT_L(0); PG8_MMA(0, 0, At, B0); PG8_BAR; PG8_SCHED;
            PG8_LDB(B1, 1, 1); PG8_STAGE(PG8_SB(1, 0), b3, voffB);
            PG8_BAR; PG8_WAIT_L(0); PG8_MMA(0, 1, At, B1); PG8_BAR;
            PG8_LDA(At, 1, 1); PG8_STAGE(PG8_SA(1, 0), a3, voffA);
            PG8_BAR; PG8_WAIT_L(0); PG8_MMA(1, 0, At, B0); PG8_BAR; PG8_SCHED;
            PG8_STAGE(PG8_SB(1, 1), b3 + hstep, voffB);
            PG8_WAIT_V(6); PG8_BAR; PG8_MMA(1, 1, At, B1); PG8_BAR;
        }
        E(acc, cur, wr, wc, fr, fq); S.done(cur);
        if (!has_next) break;
#pragma unroll
        for (int a = 0; a < 2; ++a)
#pragma unroll
            for (int b = 0; b < 2; ++b)
#pragma unroll
                for (int m = 0; m < 4; ++m)
#pragma unroll
                    for (int n = 0; n < 2; ++n) acc[a][b][m][n] = (f32x4){0.f, 0.f, 0.f, 0.f};
        cur = nxt; cA = nA; cB = nB; ++ui;
    }
    PG8_WAIT_V(0);
    if (wr == 0) PG8_BAR;
    PG8_BAR;
#undef PG8_SA
#undef PG8_SB
#undef PG8_STAGE
#undef PG8_LDA
#undef PG8_LDB
#undef PG8_MMA
#undef PG8_WAIT_V
#undef PG8_WAIT_L
#undef PG8_BAR
#undef PG8_SCHED
}
}

namespace att {
constexpr int D = 128, NW = 8, QBLK = 32, KVBLK = 64;
constexpr float SCALE = 0.088388347648318440f;
constexpr float THR = 8.f;
constexpr size_t SHM_V = KVBLK * D * 2, SHM_K = KVBLK * D * 2, SHM_ATTN = 2 * SHM_V + 2 * SHM_K + NW * 64 * 4;
#define KSWZ(row, colB) ((row) * 256 + ((colB) ^ (((row) & 7) << 4)))
#define SBAR() __builtin_amdgcn_sched_barrier(0)
__device__ __forceinline__ int crow(int r, int hi) { return (r & 3) + 8 * (r >> 2) + 4 * hi; }
__device__ __forceinline__ void partialSM(f32x16& p0, f32x16& p1, float& m_reg, float& mn, float& alpha) {
  constexpr float C = SCALE * 1.4426950408889634f;
  float pmax = p0[0];
#pragma unroll
  for (int r = 1; r < 16; ++r) pmax = fmaxf(pmax, p0[r]);
#pragma unroll
  for (int r = 0; r < 16; ++r) pmax = fmaxf(pmax, p1[r]);
  { auto rr = __builtin_amdgcn_permlane32_swap(__float_as_uint(pmax), __float_as_uint(pmax), false, false);
    pmax = fmaxf(__uint_as_float(rr[0]), __uint_as_float(rr[1])); }
  if (__builtin_expect(__all(pmax - m_reg <= THR / SCALE), 1)) { mn = m_reg; alpha = 1.f; }
  else { mn = fmaxf(m_reg, pmax); alpha = __builtin_amdgcn_exp2f((m_reg - mn) * C); m_reg = mn; }
  float mnC = -mn * C;
#pragma unroll
  for (int r = 0; r < 16; ++r) p0[r] = fmaf(p0[r], C, mnC);
#pragma unroll
  for (int r = 0; r < 16; ++r) p1[r] = fmaf(p1[r], C, mnC);
#pragma unroll
  for (int r = 0; r < 16; ++r) p0[r] = __builtin_amdgcn_exp2f(p0[r]);
}
__device__ __forceinline__ void finishSM(f32x16& p0, f32x16& p1, float alpha, float& l_reg, bf16x8& pa0, bf16x8& pa1, bf16x8& pa2, bf16x8& pa3) {
#pragma unroll
  for (int r = 0; r < 16; ++r) p1[r] = __builtin_amdgcn_exp2f(p1[r]);
  float ps = 0;
#pragma unroll
  for (int r = 0; r < 16; ++r) ps += p0[r];
#pragma unroll
  for (int r = 0; r < 16; ++r) ps += p1[r];
  { auto rr = __builtin_amdgcn_permlane32_swap(__float_as_uint(ps), __float_as_uint(ps), false, false);
    ps = __uint_as_float(rr[0]) + __uint_as_float(rr[1]); }
  l_reg = l_reg * alpha + ps;
#define PK4(P, BASE, OUT) do { unsigned a0 = cvt_pk_bf16(P[BASE + 0], P[BASE + 1]), a1 = cvt_pk_bf16(P[BASE + 2], P[BASE + 3]);   \
    unsigned b0 = cvt_pk_bf16(P[BASE + 4], P[BASE + 5]), b1 = cvt_pk_bf16(P[BASE + 6], P[BASE + 7]);                              \
    auto r0 = __builtin_amdgcn_permlane32_swap(a0, b0, false, false); auto r1 = __builtin_amdgcn_permlane32_swap(a1, b1, false, false); \
    u32x4 w = {r0[0], r1[0], r0[1], r1[1]}; OUT = *reinterpret_cast<bf16x8*>(&w); } while (0)
  PK4(p0, 0, pa0); PK4(p0, 8, pa1); PK4(p1, 0, pa2); PK4(p1, 8, pa3);
#undef PK4
}
__device__ __forceinline__ void qkt(f32x16& p0, f32x16& p1, const bf16_t* Ks, const bf16x8* qr, int r32, int hi) {
  p0 = f32x16{}; p1 = f32x16{};
#pragma unroll
  for (int d0 = 0; d0 < 8; ++d0) { int cb = (d0 * 16 + hi * 8) * 2;
    bf16x8 b0 = *reinterpret_cast<const bf16x8*>((const char*)Ks + KSWZ(r32, cb));
    bf16x8 b1 = *reinterpret_cast<const bf16x8*>((const char*)Ks + KSWZ(32 + r32, cb));
    p0 = __builtin_amdgcn_mfma_f32_32x32x16_bf16(b0, qr[d0], p0, 0, 0, 0);
    p1 = __builtin_amdgcn_mfma_f32_32x32x16_bf16(b1, qr[d0], p1, 0, 0, 0); }
}
__device__ __forceinline__ int v_st(int k, int c) { const int kk = (k & ~0xC) | ((k & 4) << 1) | ((k & 8) >> 1); return ((kk >> 3) * 4 + (c >> 5)) * 512 + ((kk & 7) * 32 + (c & 31)) * 2; }
__device__ __forceinline__ int v_rd_base(int lane) { return ((lane & 3) << 3) | (((lane >> 2) & 3) << 6) | (((lane >> 4) & 1) << 5) | (((lane >> 5) & 1) << 8); }
constexpr int v_rd_off(int d0, int ks, int half) { return d0 * 512 + ks * 4096 + half * 2048; }
template <int OFF> __device__ __forceinline__ s16x4 tr_read(int vb) {
  s16x4 r; asm volatile("ds_read_b64_tr_b16 %0, %1 offset:%2" : "=&v"(r) : "v"(vb), "i"(OFF) : "memory"); return r;
}
template <int D0> __device__ __forceinline__ void pv_one(f32x16& od, int vb, bf16x8 pa0, bf16x8 pa1, bf16x8 pa2, bf16x8 pa3) {
  const s16x4 l0 = tr_read<v_rd_off(D0, 0, 0)>(vb), h0 = tr_read<v_rd_off(D0, 0, 1)>(vb), l1 = tr_read<v_rd_off(D0, 1, 0)>(vb), h1 = tr_read<v_rd_off(D0, 1, 1)>(vb);
  const s16x4 l2 = tr_read<v_rd_off(D0, 2, 0)>(vb), h2 = tr_read<v_rd_off(D0, 2, 1)>(vb), l3 = tr_read<v_rd_off(D0, 3, 0)>(vb), h3 = tr_read<v_rd_off(D0, 3, 1)>(vb);
  asm volatile("s_waitcnt lgkmcnt(0)" ::: "memory"); SBAR();
#define PK(L, H) (bf16x8){L[0], L[1], L[2], L[3], H[0], H[1], H[2], H[3]}
  od = __builtin_amdgcn_mfma_f32_32x32x16_bf16(pa0, PK(l0, h0), od, 0, 0, 0);
  od = __builtin_amdgcn_mfma_f32_32x32x16_bf16(pa1, PK(l1, h1), od, 0, 0, 0);
  od = __builtin_amdgcn_mfma_f32_32x32x16_bf16(pa2, PK(l2, h2), od, 0, 0, 0);
  od = __builtin_amdgcn_mfma_f32_32x32x16_bf16(pa3, PK(l3, h3), od, 0, 0, 0);
#undef PK
}
__device__ __forceinline__ void pv_d0(f32x16* o, int vb, bf16x8 pa0, bf16x8 pa1, bf16x8 pa2, bf16x8 pa3) {
  pv_one<0>(o[0], vb, pa0, pa1, pa2, pa3); pv_one<1>(o[1], vb, pa0, pa1, pa2, pa3); pv_one<2>(o[2], vb, pa0, pa1, pa2, pa3); pv_one<3>(o[3], vb, pa0, pa1, pa2, pa3);
}
template <int LDQ, int LDK, int LDO>
__device__ __forceinline__ void attn_dense_body(const bf16_t* __restrict__ Qb, const bf16_t* __restrict__ Kh, const bf16_t* __restrict__ Vh,
                                                bf16_t* __restrict__ Ob, int seq, char* lds) {
  const int tid = threadIdx.x, wid = tid >> 6, lane = tid & 63, r32 = lane & 31, hi = lane >> 5;
  bf16_t* V_lds = (bf16_t*)lds; bf16_t* K_lds = (bf16_t*)(lds + 2 * SHM_V);
  float* ws = (float*)(lds + 2 * SHM_V + 2 * SHM_K) + wid * 64; float* li_l = ws; float* al_l = ws + 32;
  float m_reg = -1e30f, l_reg = 0; f32x16 o[4] = {}; bf16x8 qr[8];
  const bf16_t* Qw = Qb + (long)(wid * QBLK + r32) * LDQ + hi * 8;
#pragma unroll
  for (int d0 = 0; d0 < 8; ++d0) qr[d0] = *reinterpret_cast<const bf16x8*>(Qw + d0 * 16);
  const int sr = tid >> 4, sc = (tid & 15) * 8, vst0 = v_st(sr, sc), vst1 = v_st(32 + sr, sc);
  const int vb0 = (int)(uintptr_t)V_lds + v_rd_base(lane);
  struct { bf16x8 vs0, vs1, ks0, ks1; } sr_[2];
#define SLOAD(i, k0) do { sr_[i].vs0 = *(const bf16x8*)(&Vh[(long)((k0) + sr) * LDK + sc]); sr_[i].vs1 = *(const bf16x8*)(&Vh[(long)((k0) + 32 + sr) * LDK + sc]); \
    sr_[i].ks0 = *(const bf16x8*)(&Kh[(long)((k0) + sr) * LDK + sc]); sr_[i].ks1 = *(const bf16x8*)(&Kh[(long)((k0) + 32 + sr) * LDK + sc]); } while (0)
#define SWRITE(b, i) do { *(bf16x8*)((char*)V_lds + (b) * SHM_V + vst0) = sr_[i].vs0;          \
    *(bf16x8*)((char*)V_lds + (b) * SHM_V + vst1) = sr_[i].vs1; int kc = sc * 2;               \
    *(bf16x8*)((char*)K_lds + (b) * SHM_K + KSWZ(sr, kc)) = sr_[i].ks0;                       \
    *(bf16x8*)((char*)K_lds + (b) * SHM_K + KSWZ(32 + sr, kc)) = sr_[i].ks1; } while (0)
#define SWAIT() asm volatile("s_waitcnt vmcnt(4)" ::: "memory")
#define RESC(a) do { if (__any((a) < 1.f)) { if (hi == 0) al_l[r32] = (a); asm volatile("s_waitcnt lgkmcnt(0)" ::: "memory"); \
    _Pragma("unroll") for (int d = 0; d < 4; ++d) _Pragma("unroll") for (int r = 0; r < 16; ++r) o[d][r] *= al_l[crow(r, hi)]; } } while (0)
  f32x16 pA0, pA1, pB0, pB1; float mnA, mnB, alA, alB; bf16x8 pa0, pa1, pa2, pa3; const int NT = seq / KVBLK;
  constexpr int SE = 0, SO = 1;
  SLOAD(SE, 0); asm volatile("s_waitcnt vmcnt(0)" ::: "memory"); SWRITE(0, SE); __syncthreads();
  qkt(pA0, pA1, K_lds, qr, r32, hi); partialSM(pA0, pA1, m_reg, mnA, alA);
  SLOAD(SO, KVBLK); if (2 < NT) SLOAD(SE, 2 * KVBLK);
  SWAIT(); SWRITE(1, SO); __syncthreads();
  for (int j = 1; j + 1 < NT; j += 2) {
    SBAR(); qkt(pB0, pB1, (bf16_t*)((char*)K_lds + SHM_K), qr, r32, hi);
    finishSM(pA0, pA1, alA, l_reg, pa0, pa1, pa2, pa3); SBAR();
    SLOAD(SO, (j + 2) * KVBLK); SBAR();
    pv_d0(o, vb0, pa0, pa1, pa2, pa3); partialSM(pB0, pB1, m_reg, mnB, alB);
    __syncthreads(); SWAIT(); SWRITE(0, SE);
    RESC(alB); __syncthreads();
    SBAR(); qkt(pA0, pA1, K_lds, qr, r32, hi);
    finishSM(pB0, pB1, alB, l_reg, pa0, pa1, pa2, pa3); SBAR();
    if (j + 3 < NT) SLOAD(SE, (j + 3) * KVBLK); SBAR();
    pv_d0(o, vb0 + (int)SHM_V, pa0, pa1, pa2, pa3); partialSM(pA0, pA1, m_reg, mnA, alA);
    __syncthreads(); SWAIT(); SWRITE(1, SO);
    RESC(alA); __syncthreads();
  }
  SBAR(); qkt(pB0, pB1, (bf16_t*)((char*)K_lds + SHM_K), qr, r32, hi);
  finishSM(pA0, pA1, alA, l_reg, pa0, pa1, pa2, pa3); SBAR();
  pv_d0(o, vb0, pa0, pa1, pa2, pa3); partialSM(pB0, pB1, m_reg, mnB, alB);
  __syncthreads(); RESC(alB);
  finishSM(pB0, pB1, alB, l_reg, pa0, pa1, pa2, pa3); SBAR();
  pv_d0(o, vb0 + (int)SHM_V, pa0, pa1, pa2, pa3);
  if (hi == 0) li_l[r32] = l_reg; asm volatile("s_waitcnt lgkmcnt(0)" ::: "memory");
  float rli[16];
#pragma unroll
  for (int r = 0; r < 16; ++r) rli[r] = __builtin_amdgcn_rcpf(li_l[crow(r, hi)]);
  bf16_t* Ow = Ob + (long)(wid * QBLK) * LDO;
#pragma unroll
  for (int r = 0; r < 16; ++r) { int orow = crow(r, hi);
#pragma unroll
    for (int d0 = 0; d0 < 4; ++d0) Ow[(long)orow * LDO + d0 * 32 + r32] = f2bf(o[d0][r] * rli[r]); }
#undef SLOAD
#undef SWRITE
#undef SWAIT
#undef RESC
}
}

__device__ __forceinline__ void transpose_tile(const float* __restrict__ W, bf16_t* __restrict__ Wt, int K, int N, int tk, int tn, float* tile, bool is_win) {
    const int tid = threadIdx.x;
    float4 v[8];
#pragma unroll
    for (int i = 0; i < 8; ++i) { const f32x4 t4 = __builtin_nontemporal_load((const f32x4*)(W + (size_t)(tk * 64 + (tid >> 6) + 8 * i) * N + tn * 256 + (tid & 63) * 4)); v[i] = (float4){t4[0], t4[1], t4[2], t4[3]}; }
#pragma unroll
    for (int i = 0; i < 8; ++i) { float* tp = tile + ((tid >> 6) + 8 * i) * 257 + (tid & 63) * 4; tp[0] = v[i].x; tp[1] = v[i].y; tp[2] = v[i].z; tp[3] = v[i].w; }
    __syncthreads();
    const int n = tid >> 1, k0 = (tid & 1) * 32; const int col = tn * 256 + n;
    const float s = (is_win && col >= C_KR && col < C_VR) ? 0.08838834764831845f : 1.f;
#pragma unroll
    for (int q = 0; q < 4; ++q) { float f[8];
#pragma unroll
        for (int j = 0; j < 8; ++j) f[j] = tile[(k0 + q * 8 + j) * 257 + n] * s;
        u32x4 w; w.x = cvt_pk_bf16(f[0], f[1]); w.y = cvt_pk_bf16(f[2], f[3]); w.z = cvt_pk_bf16(f[4], f[5]); w.w = cvt_pk_bf16(f[6], f[7]);
        *(u32x4*)(Wt + (size_t)col * K + tk * 64 + k0 + q * 8) = w; }
    __syncthreads();
}
__device__ __forceinline__ void cvt_stream(const float* __restrict__ src, bf16_t* __restrict__ dst, size_t n8, size_t gtid, size_t gthreads) {
    for (size_t i = gtid; i < n8; i += gthreads) {
        const float4 a = *(const float4*)(src + i * 8), b = *(const float4*)(src + i * 8 + 4);
        u32x4 w; w.x = cvt_pk_bf16(a.x, a.y); w.y = cvt_pk_bf16(a.z, a.w); w.z = cvt_pk_bf16(b.x, b.y); w.w = cvt_pk_bf16(b.z, b.w);
        *(u32x4*)(dst + i * 8) = w;
    }
}
__device__ __forceinline__ void phase_prep(const Params& p, unsigned char* smem) {
    const int tid = threadIdx.x, G = gridDim.x, bx = blockIdx.x;
    float* tile = (float*)smem;
    bf16_t* wtin = (bf16_t*)(p.ws + WS_WTIN); bf16_t* wto = (bf16_t*)(p.ws + WS_WTO); bf16_t* wtq = (bf16_t*)(p.ws + WS_WTQ);
    constexpr int T_IN = 32 * 22, T_O = 32 * 8;
    for (int t = bx; t < T_IN + 2 * T_O; t += G) {
        if (t < T_IN) transpose_tile(p.w_in, wtin, DM, NCOL, t / 22, t % 22, tile, true);
        else if (t < T_IN + T_O) { const int u = t - T_IN; transpose_tile(p.w_o, wto, DM, DM, u >> 3, u & 7, tile, false); }
        else { const int u = t - T_IN - T_O; transpose_tile(p.w_q, wtq, DM, DM, u >> 3, u & 7, tile, false); }
    }
    cvt_stream(p.sub_keys, (bf16_t*)(p.ws + WS_KEYS), 262144 / 8, (size_t)bx * NTHREADS + tid, (size_t)G * NTHREADS);
    float* mod = (float*)(p.ws + WS_MOD);
    for (int bi = bx; bi < 192; bi += G) {
        const int ks = bi / 6, cg4 = (bi % 6) * 512 + tid;
        __syncthreads();
        if (tid < 192) { const int c = tid >> 6, kk = tid & 63; const int k = ks * 64 + kk;
            const float v = (c == 0) ? p.c_ctx[k] : p.c[(c - 1) * DM + k]; tile[tid] = silu_f(v); }
        __syncthreads();
        float4 a0 = {0, 0, 0, 0}, a1 = a0, a2 = a0;
        const float* wp = p.w_ada + (size_t)(ks * 64) * 12288 + cg4 * 4;
#pragma unroll 8
        for (int kk = 0; kk < 64; ++kk) { const f32x4 w4 = __builtin_nontemporal_load((const f32x4*)(wp + (size_t)kk * 12288)); const float4 w = {w4[0], w4[1], w4[2], w4[3]};
            const float s0 = tile[kk], s1 = tile[64 + kk], s2 = tile[128 + kk];
            a0.x += s0 * w.x; a0.y += s0 * w.y; a0.z += s0 * w.z; a0.w += s0 * w.w;
            a1.x += s1 * w.x; a1.y += s1 * w.y; a1.z += s1 * w.z; a1.w += s1 * w.w;
            a2.x += s2 * w.x; a2.y += s2 * w.y; a2.z += s2 * w.z; a2.w += s2 * w.w; }
        if (ks == 0) { const float4 b = *(const float4*)(p.b_ada + cg4 * 4);
            a0.x += b.x; a0.y += b.y; a0.z += b.z; a0.w += b.w; a1.x += b.x; a1.y += b.y; a1.z += b.z; a1.w += b.w; a2.x += b.x; a2.y += b.y; a2.z += b.z; a2.w += b.w; }
        float* m0 = mod + cg4 * 4;
        atomicAdd(m0 + 0, a0.x); atomicAdd(m0 + 1, a0.y); atomicAdd(m0 + 2, a0.z); atomicAdd(m0 + 3, a0.w);
        atomicAdd(m0 + 12288 + 0, a1.x); atomicAdd(m0 + 12288 + 1, a1.y); atomicAdd(m0 + 12288 + 2, a1.z); atomicAdd(m0 + 12288 + 3, a1.w);
        atomicAdd(m0 + 24576 + 0, a2.x); atomicAdd(m0 + 24576 + 1, a2.y); atomicAdd(m0 + 24576 + 2, a2.z); atomicAdd(m0 + 24576 + 3, a2.w);
    }
    __syncthreads();
}

__device__ __forceinline__ void phase_h1(const Params& p) {
    const size_t gtid = (size_t)blockIdx.x * NTHREADS + threadIdx.x, gth = (size_t)gridDim.x * NTHREADS;
    const float* mod = (const float*)(p.ws + WS_MOD); bf16_t* H = (bf16_t*)(p.ws + WS_H);
    constexpr size_t NG = (size_t)TT * (DM / 8);
    for (size_t i0 = gtid; i0 < NG; i0 += 4 * gth) {
        float4 xa[4], xb[4];
#pragma unroll
        for (int u = 0; u < 4; ++u) { const size_t i = i0 + u * gth; if (i < NG) { const int t = (int)(i >> 8), c8 = (int)(i & 255) * 8; const float* xr = x_row(p, t) + c8;
            const f32x4 xa4 = __builtin_nontemporal_load((const f32x4*)xr), xb4 = __builtin_nontemporal_load((const f32x4*)(xr + 4)); xa[u] = (float4){xa4[0], xa4[1], xa4[2], xa4[3]}; xb[u] = (float4){xb4[0], xb4[1], xb4[2], xb4[3]}; } }
#pragma unroll
        for (int u = 0; u < 4; ++u) { const size_t i = i0 + u * gth; if (i < NG) { const int t = (int)(i >> 8), c8 = (int)(i & 255) * 8; const float* m = mod + (size_t)cond_of(t) * 12288;
            const float4 sha = *(const float4*)(m + c8), shb = *(const float4*)(m + c8 + 4);
            const float4 sca = *(const float4*)(m + 2048 + c8), scb = *(const float4*)(m + 2048 + c8 + 4);
            u32x4 w;
            w.x = cvt_pk_bf16(xa[u].x * (1.f + sca.x) + sha.x, xa[u].y * (1.f + sca.y) + sha.y);
            w.y = cvt_pk_bf16(xa[u].z * (1.f + sca.z) + sha.z, xa[u].w * (1.f + sca.w) + sha.w);
            w.z = cvt_pk_bf16(xb[u].x * (1.f + scb.x) + shb.x, xb[u].y * (1.f + scb.y) + shb.y);
            w.w = cvt_pk_bf16(xb[u].z * (1.f + scb.z) + shb.z, xb[u].w * (1.f + scb.w) + shb.w);
            *(u32x4*)(H + (size_t)t * DM + c8) = w; } }
    }
}

__device__ __forceinline__ void phase_postproj(const Params& p) {
    const int lane = threadIdx.x & 63; const int gw = blockIdx.x * 8 + (threadIdx.x >> 6), nw = gridDim.x * 8;
    bf16_t* P = (bf16_t*)(p.ws + WS_A);
    bf16_t* KC = (bf16_t*)(p.ws + WS_KC); bf16_t* VC = (bf16_t*)(p.ws + WS_VC); bf16_t* KL = (bf16_t*)(p.ws + WS_KL); bf16_t* VL = (bf16_t*)(p.ws + WS_VL);
    const int grp = lane >> 4, l16 = lane & 15, d0 = l16 * 8, sec = l16 >> 2;
    float invf[8], qg[8], kg[8];
#pragma unroll
    for (int i = 0; i < 8; ++i) { invf[i] = exp2f(-(float)((l16 & 3) * 8 + i) * (13.287712379549449f / 32.f)) * 0.15915494309189535f;
        qg[i] = p.qn_g[d0 + i]; kg[i] = p.kn_g[d0 + i]; }
    for (int t = gw; t < TT; t += nw) {
        const bool lat = t >= TP; const int tl = lat ? t - TP : t;
        bf16_t* rowp = P + (size_t)t * NCOL;
        const u32x4 wa = *(const u32x4*)(rowp + C_QA + grp * 128 + d0), wb = *(const u32x4*)(rowp + C_QA + (grp + 4) * 128 + d0), wc = *(const u32x4*)(rowp + C_KA + grp * 128 + d0);
        float cs[8], sn[8];
        if (lat) { const int l = tl & 4095; const float pos = (float)(sec < 2 ? (l >> 6) : (l & 63));
#pragma unroll
            for (int i = 0; i < 8; ++i) { const float rev = pos * invf[i]; const float fr = rev - floorf(rev); sn[i] = __builtin_amdgcn_sinf(fr); cs[i] = __builtin_amdgcn_cosf(fr); } }
        else {
#pragma unroll
            for (int i = 0; i < 8; ++i) { cs[i] = 1.f; sn[i] = 0.f; } }
        const float sgn = (sec & 1) ? 1.f : -1.f;
        float xa[8], xb[8], xc[8];
#pragma unroll
        for (int e = 0; e < 4; ++e) { xa[2 * e] = bf_lo(wa[e]); xa[2 * e + 1] = bf_hi(wa[e]); xb[2 * e] = bf_lo(wb[e]); xb[2 * e + 1] = bf_hi(wb[e]); xc[2 * e] = bf_lo(wc[e]); xc[2 * e + 1] = bf_hi(wc[e]); }
        float sa = 0.f, sb = 0.f, sc2 = 0.f;
#pragma unroll
        for (int i = 0; i < 8; ++i) { sa += xa[i] * xa[i]; sb += xb[i] * xb[i]; sc2 += xc[i] * xc[i]; }
#pragma unroll
        for (int o = 1; o < 16; o <<= 1) { sa += __shfl_xor(sa, o); sb += __shfl_xor(sb, o); sc2 += __shfl_xor(sc2, o); }
        const float ra = rsqrtf(sa * (1.f / 128.f) + EPS), rb = rsqrtf(sb * (1.f / 128.f) + EPS), rc = rsqrtf(sc2 * (1.f / 128.f) + EPS);
        float oa[8], ob[8], oc[8];
#pragma unroll
        for (int i = 0; i < 8; ++i) { const float ya = xa[i] * ra * qg[i], yb = xb[i] * rb * qg[i], yc = xc[i] * rc * kg[i];
            const float za = __shfl_xor(ya, 4), zb = __shfl_xor(yb, 4), zc = __shfl_xor(yc, 4);
            oa[i] = ya * cs[i] + sgn * za * sn[i]; ob[i] = yb * cs[i] + sgn * zb * sn[i]; oc[i] = yc * cs[i] + sgn * zc * sn[i]; }
        u32x4 pa, pb, pc;
#pragma unroll
        for (int e = 0; e < 4; ++e) { pa[e] = cvt_pk_bf16(oa[2 * e], oa[2 * e + 1]); pb[e] = cvt_pk_bf16(ob[2 * e], ob[2 * e + 1]); pc[e] = cvt_pk_bf16(oc[2 * e], oc[2 * e + 1]); }
        *(u32x4*)(rowp + C_QA + grp * 128 + d0) = pa; *(u32x4*)(rowp + C_QA + (grp + 4) * 128 + d0) = pb;
        const int kvh = grp & 1; const bool isk = grp < 2;
        const u32x4 outw = isk ? pc : wc;
        if (!lat) { const int b = tl >> 8, pos = tl & 255;
            bf16_t* dst = (isk ? KC : VC) + ((size_t)(b * 2 + kvh) * 256 + pos) * 128 + d0; *(u32x4*)dst = outw;
            float* od = p.out + (isk ? O_CK : O_CV) + ((size_t)(b * 256 + pos) * 2 + kvh) * 128 + d0;
            float4 f0, f1;
            if (isk) { f0 = (float4){oc[0], oc[1], oc[2], oc[3]}; f1 = (float4){oc[4], oc[5], oc[6], oc[7]}; }
            else { f0 = (float4){xc[0], xc[1], xc[2], xc[3]}; f1 = (float4){xc[4], xc[5], xc[6], xc[7]}; }
            *(float4*)od = f0; *(float4*)(od + 4) = f1;
        } else { const int b = tl >> 12, l = tl & 4095;
            bf16_t* dst = (isk ? KL : VL) + ((size_t)(b * 2 + kvh) * SKV_L + 256 + l) * 128 + d0; *(u32x4*)dst = outw; }
    }
    for (int task = gw; task < 2 * 256 * 2; task += nw) {
        const int b = task >> 9, pos = (task >> 1) & 255, kvh = task & 1;
        const float* ck = p.cache_k + ((size_t)(b * 256 + pos) * 2 + kvh) * 128; const float* cv = p.cache_v + ((size_t)(b * 256 + pos) * 2 + kvh) * 128;
        bf16_t* kd = KL + ((size_t)(b * 2 + kvh) * SKV_L + pos) * 128; bf16_t* vd = VL + ((size_t)(b * 2 + kvh) * SKV_L + pos) * 128;
        kd[lane] = f2bf(ck[lane]); kd[lane + 64] = f2bf(ck[lane + 64]); vd[lane] = f2bf(cv[lane]); vd[lane + 64] = f2bf(cv[lane + 64]);
    }
}

struct RetItem { int tok0, h, seqk; };
__device__ __forceinline__ void ret_item(int it, int& tok0, int& h) {
    if (it < 256) { const int s = it >> 4; h = (it >> 1) & 7; tok0 = s * 256 + (it & 1) * 128; }
    else { const int u = it - 256; const int s = u >> 8; h = (u >> 5) & 7; tok0 = TP + s * 4096 + (u & 31) * 128; }
}
constexpr int RS = 136;

__device__ __forceinline__ void phase_chunk_kv(const Params& p, unsigned char* smem) {
    const int tid = threadIdx.x, lane = tid & 63, wid = tid >> 6, fr = lane & 15, fq = lane >> 4;
    const bf16_t* P = (const bf16_t*)(p.ws + WS_A); bf16_t* KVC = (bf16_t*)(p.ws + WS_B);
    bf16_t* KT = (bf16_t*)smem; bf16_t* VFT = KT + 128 * RS; bf16_t* VBT = VFT + 128 * RS;
    for (int it = blockIdx.x; it < 768; it += gridDim.x) {
        int tok0, h; ret_item(it, tok0, h);
        const float lgf = log_sigmoid(p.decay[h]), lgb = log_sigmoid(p.decay[8 + h]);
        { const int j = tid & 127, dq = tid >> 7;
          const float zf = __expf(lgf * (float)(127 - j)), zb = __expf(lgb * (float)j);
          const bf16_t* kp = P + (size_t)(tok0 + j) * NCOL + C_KR + h * 128 + dq * 32; const bf16_t* vp = P + (size_t)(tok0 + j) * NCOL + C_VR + h * 128 + dq * 32;
          u32x4 kwv[4], vwv[4];
#pragma unroll
          for (int q = 0; q < 4; ++q) { kwv[q] = *(const u32x4*)(kp + q * 8); vwv[q] = *(const u32x4*)(vp + q * 8); }
          __syncthreads();
#pragma unroll
          for (int q = 0; q < 4; ++q) { const u32x4 kw = kwv[q]; const u32x4 vw = vwv[q];
              bf16_t* kt = KT + (dq * 32 + q * 8) * RS + j; bf16_t* vf = VFT + (dq * 32 + q * 8) * RS + j; bf16_t* vb = VBT + (dq * 32 + q * 8) * RS + j;
#pragma unroll
              for (int e = 0; e < 4; ++e) {
                  kt[(2 * e) * RS] = (bf16_t)(kw[e] & 0xffffu); kt[(2 * e + 1) * RS] = (bf16_t)(kw[e] >> 16);
                  const float v0 = bf_lo(vw[e]), v1 = bf_hi(vw[e]);
                  vf[(2 * e) * RS] = f2bf(v0 * zf); vf[(2 * e + 1) * RS] = f2bf(v1 * zf);
                  vb[(2 * e) * RS] = f2bf(v0 * zb); vb[(2 * e + 1) * RS] = f2bf(v1 * zb); } } }
        __syncthreads();
        const int dir = wid >> 2, n0 = (wid & 3) * 32; const bf16_t* VT = dir ? VBT : VFT;
        f32x4 acc[8][2];
#pragma unroll
        for (int m = 0; m < 8; ++m) { acc[m][0] = (f32x4){0, 0, 0, 0}; acc[m][1] = (f32x4){0, 0, 0, 0}; }
#pragma unroll 1
        for (int ks = 0; ks < 4; ++ks) {
            const bf16x8 b0 = *(const bf16x8*)(VT + (n0 + fr) * RS + ks * 32 + fq * 8), b1 = *(const bf16x8*)(VT + (n0 + 16 + fr) * RS + ks * 32 + fq * 8);
            const bf16_t* ap = KT + fr * RS + ks * 32 + fq * 8;
#pragma unroll
            for (int m = 0; m < 8; ++m) { const bf16x8 a = *(const bf16x8*)(ap + m * 16 * RS);
                acc[m][0] = __builtin_amdgcn_mfma_f32_16x16x32_bf16(a, b0, acc[m][0], 0, 0, 0);
                acc[m][1] = __builtin_amdgcn_mfma_f32_16x16x32_bf16(a, b1, acc[m][1], 0, 0, 0); } }
        bf16_t* dst = KVC + ((size_t)it * 2 + dir) * 16384;
#pragma unroll
        for (int m = 0; m < 8; ++m)
#pragma unroll
            for (int n = 0; n < 2; ++n)
#pragma unroll
                for (int r = 0; r < 4; ++r) dst[(m * 16 + fq * 4 + r) * 128 + n0 + n * 16 + fr] = f2bf(acc[m][n][r]);
    }
    __syncthreads();
}

__device__ __forceinline__ void phase_scan(const Params& p) {
    const int gtid = blockIdx.x * NTHREADS + threadIdx.x, gth = gridDim.x * NTHREADS;
    const bf16_t* KVC = (const bf16_t*)(p.ws + WS_B); bf16_t* SP = (bf16_t*)(p.ws + WS_D);
    for (int u = gtid; u < 32 * 4096; u += gth) {
        const int sq = u >> 12, e4 = (u & 4095) * 4; const int b = sq >> 4, h = (sq >> 1) & 7, dir = sq & 1;
        const float g128 = __expf(128.f * log_sigmoid(p.decay[dir * 8 + h]));
        float4 S = *(const float4*)(p.state_ret + ((size_t)(b * 2 + dir) * 8 + h) * 16384 + e4);
        const int it0 = 256 + (b * 8 + h) * 32;
#pragma unroll 8
        for (int st = 0; st < 32; ++st) { const int c = dir ? 31 - st : st; const size_t o = ((size_t)(it0 + c) * 2 + dir) * 16384 + e4;
            const u32x2 kvw = *(const u32x2*)(KVC + o); const float4 kv = {bf_lo(kvw.x), bf_hi(kvw.x), bf_lo(kvw.y), bf_hi(kvw.y)};
            u32x2 w; w.x = cvt_pk_bf16(S.x, S.y); w.y = cvt_pk_bf16(S.z, S.w); *(u32x2*)(SP + o) = w;
            S.x = g128 * S.x + kv.x; S.y = g128 * S.y + kv.y; S.z = g128 * S.z + kv.z; S.w = g128 * S.w + kv.w; }
    }
    for (int u = gtid; u < 256 * 4096; u += gth) {
        const int sq = u >> 12, e4 = (u & 4095) * 4; const int s = sq >> 4, h = (sq >> 1) & 7, dir = sq & 1;
        const float g128 = __expf(128.f * log_sigmoid(p.decay[dir * 8 + h]));
        const int it0 = (s * 8 + h) * 2;
        const int cfirst = dir ? 1 : 0, csecond = dir ? 0 : 1;
        const size_t o1 = ((size_t)(it0 + cfirst) * 2 + dir) * 16384 + e4, o2 = ((size_t)(it0 + csecond) * 2 + dir) * 16384 + e4;
        const u32x2 k1w = *(const u32x2*)(KVC + o1), k2w = *(const u32x2*)(KVC + o2);
        const float4 k1 = {bf_lo(k1w.x), bf_hi(k1w.x), bf_lo(k1w.y), bf_hi(k1w.y)}, k2 = {bf_lo(k2w.x), bf_hi(k2w.x), bf_lo(k2w.y), bf_hi(k2w.y)};
        u32x2 z; z.x = 0u; z.y = 0u; *(u32x2*)(SP + o1) = z;
        *(u32x2*)(SP + o2) = k1w;
        float4 f; f.x = g128 * k1.x + k2.x; f.y = g128 * k1.y + k2.y; f.z = g128 * k1.z + k2.z; f.w = g128 * k1.w + k2.w;
        *(float4*)(p.out + O_STATE + ((size_t)(s * 2 + dir) * 8 + h) * 16384 + e4) = f;
    }
}

__device__ __forceinline__ void phase_attention(const Params& p, unsigned char* smem) {
    const bf16_t* P = (const bf16_t*)(p.ws + WS_A); bf16_t* MIX = (bf16_t*)(p.ws + WS_E);
    const bf16_t* KC = (const bf16_t*)(p.ws + WS_KC); const bf16_t* VC = (const bf16_t*)(p.ws + WS_VC);
    const bf16_t* KL = (const bf16_t*)(p.ws + WS_KL); const bf16_t* VL = (const bf16_t*)(p.ws + WS_VL);
    for (int it = blockIdx.x; it < 384; it += gridDim.x) {
        __syncthreads();
        if (it < 256) { const int b = it >> 7, h = (it >> 4) & 7, qb = it & 15; const int tok0 = TP + b * 4096 + qb * 256; const int kvh = h >> 2;
            att::attn_dense_body<NCOL, 128, DM>(P + (size_t)tok0 * NCOL + C_QA + h * 128, KL + (size_t)(b * 2 + kvh) * SKV_L * 128, VL + (size_t)(b * 2 + kvh) * SKV_L * 128,
                                                MIX + (size_t)tok0 * DM + 1024 + h * 128, SKV_L, (char*)smem);
        } else { const int u = it - 256; const int b = u >> 3, h = u & 7; const int tok0 = b * 256; const int kvh = h >> 2;
            att::attn_dense_body<NCOL, 128, DM>(P + (size_t)tok0 * NCOL + C_QA + h * 128, KC + (size_t)(b * 2 + kvh) * 256 * 128, VC + (size_t)(b * 2 + kvh) * 256 * 128,
                                                MIX + (size_t)tok0 * DM + 1024 + h * 128, 256, (char*)smem);
        }
    }
    __syncthreads();
}

__device__ __forceinline__ void phase_ret_out(const Params& p, unsigned char* smem) {
    const int tid = threadIdx.x, lane = tid & 63, wid = tid >> 6, fr = lane & 15, fq = lane >> 4;
    const bf16_t* P = (const bf16_t*)(p.ws + WS_A); const bf16_t* SP = (const bf16_t*)(p.ws + WS_D); bf16_t* MIX = (bf16_t*)(p.ws + WS_E);
    bf16_t* KN = (bf16_t*)smem; bf16_t* VT = KN + 128 * RS; bf16_t* SFT = VT + 128 * RS; bf16_t* SBT = SFT + 128 * RS;
    for (int it = blockIdx.x; it < 768; it += gridDim.x) {
        int tok0, h; ret_item(it, tok0, h);
        const float lgf = log_sigmoid(p.decay[h]), lgb = log_sigmoid(p.decay[8 + h]);
        { u32x4 kq[4];
#pragma unroll
          for (int q = 0; q < 4; ++q) kq[q] = *(const u32x4*)(P + (size_t)(tok0 + (tid >> 4) + 32 * q) * NCOL + C_KR + h * 128 + (tid & 15) * 8);
          const int j = tid & 127, dq = tid >> 7;
          const bf16_t* vp = P + (size_t)(tok0 + j) * NCOL + C_VR + h * 128 + dq * 32;
          const bf16_t* sf = SP + ((size_t)it * 2 + 0) * 16384 + j * 128 + dq * 32; const bf16_t* sb = SP + ((size_t)it * 2 + 1) * 16384 + j * 128 + dq * 32;
          u32x4 vwv[4], fwv[4], bwv[4];
#pragma unroll
          for (int q = 0; q < 4; ++q) { vwv[q] = *(const u32x4*)(vp + q * 8); fwv[q] = *(const u32x4*)(sf + q * 8); bwv[q] = *(const u32x4*)(sb + q * 8); }
          __syncthreads();
#pragma unroll
          for (int q = 0; q < 4; ++q) *(u32x4*)(KN + ((tid >> 4) + 32 * q) * RS + (tid & 15) * 8) = kq[q];
#pragma unroll
          for (int q = 0; q < 4; ++q) { const u32x4 vw = vwv[q], fw = fwv[q], bw = bwv[q];
              bf16_t* vt = VT + (dq * 32 + q * 8) * RS + j; bf16_t* ft = SFT + (dq * 32 + q * 8) * RS + j; bf16_t* bt = SBT + (dq * 32 + q * 8) * RS + j;
#pragma unroll
              for (int e = 0; e < 4; ++e) {
                  vt[(2 * e) * RS] = (bf16_t)(vw[e] & 0xffffu); vt[(2 * e + 1) * RS] = (bf16_t)(vw[e] >> 16);
                  ft[(2 * e) * RS] = (bf16_t)(fw[e] & 0xffffu); ft[(2 * e + 1) * RS] = (bf16_t)(fw[e] >> 16);
                  bt[(2 * e) * RS] = (bf16_t)(bw[e] & 0xffffu); bt[(2 * e + 1) * RS] = (bf16_t)(bw[e] >> 16); } } }
        const int i0 = wid * 16;
        bf16x8 qf[4], qxf[4], qxb[4];
        { const float xf = __expf(lgf * (float)(i0 + fr + 1)), xb = __expf(lgb * (float)(128 - (i0 + fr)));
#pragma unroll
          for (int ks = 0; ks < 4; ++ks) { const u32x4 w = *(const u32x4*)(P + (size_t)(tok0 + i0 + fr) * NCOL + C_QR + h * 128 + ks * 32 + fq * 8);
              qf[ks] = *reinterpret_cast<const bf16x8*>(&w); u32x4 wf, wb;
#pragma unroll
              for (int e = 0; e < 4; ++e) { const float lo = bf_lo(w[e]), hi = bf_hi(w[e]); wf[e] = cvt_pk_bf16(lo * xf, hi * xf); wb[e] = cvt_pk_bf16(lo * xb, hi * xb); }
              qxf[ks] = *reinterpret_cast<bf16x8*>(&wf); qxb[ks] = *reinterpret_cast<bf16x8*>(&wb); } }
        __syncthreads();
        bf16x8 pa[4];
        {
            f32x4 sc[8];
#pragma unroll
            for (int mt = 0; mt < 8; ++mt) { sc[mt] = (f32x4){0, 0, 0, 0};
                const bf16_t* kp = KN + (mt * 16 + fr) * RS + fq * 8;
#pragma unroll
                for (int ks = 0; ks < 4; ++ks) { const bf16x8 a = *(const bf16x8*)(kp + ks * 32);
                    sc[mt] = __builtin_amdgcn_mfma_f32_16x16x32_bf16(a, qf[ks], sc[mt], 0, 0, 0); } }
            const int i = i0 + fr;
#pragma unroll
            for (int mt = 0; mt < 8; ++mt)
#pragma unroll
                for (int r = 0; r < 4; ++r) { const int j = mt * 16 + fq * 4 + r; const int df = i - j;
                    const float m = df > 0 ? __expf(lgf * (float)df) : (df < 0 ? __expf(lgb * (float)(-df)) : 2.f);
                    sc[mt][r] *= m; }
#pragma unroll
            for (int s = 0; s < 4; ++s) { u32x4 w; w.x = cvt_pk_bf16(sc[2 * s][0], sc[2 * s][1]); w.y = cvt_pk_bf16(sc[2 * s][2], sc[2 * s][3]);
                w.z = cvt_pk_bf16(sc[2 * s + 1][0], sc[2 * s + 1][1]); w.w = cvt_pk_bf16(sc[2 * s + 1][2], sc[2 * s + 1][3]); pa[s] = *reinterpret_cast<bf16x8*>(&w); }
        }
        f32x4 oa[8];
#pragma unroll
        for (int nt = 0; nt < 8; ++nt) { oa[nt] = (f32x4){0, 0, 0, 0};
            const int dv = nt * 16 + fr;
#pragma unroll
            for (int s = 0; s < 4; ++s) {
                const u32x2 lo = *(const u32x2*)(VT + dv * RS + s * 32 + fq * 4), hi = *(const u32x2*)(VT + dv * RS + s * 32 + 16 + fq * 4);
                u32x4 bw; bw.x = lo.x; bw.y = lo.y; bw.z = hi.x; bw.w = hi.y;
                oa[nt] = __builtin_amdgcn_mfma_f32_16x16x32_bf16(pa[s], *reinterpret_cast<bf16x8*>(&bw), oa[nt], 0, 0, 0);
                const bf16x8 bf = *(const bf16x8*)(SFT + dv * RS + s * 32 + fq * 8), bb = *(const bf16x8*)(SBT + dv * RS + s * 32 + fq * 8);
                oa[nt] = __builtin_amdgcn_mfma_f32_16x16x32_bf16(qxf[s], bf, oa[nt], 0, 0, 0);
                oa[nt] = __builtin_amdgcn_mfma_f32_16x16x32_bf16(qxb[s], bb, oa[nt], 0, 0, 0); }
            asm volatile("" ::: "memory"); }
#pragma unroll
        for (int r = 0; r < 4; ++r) { const int i = i0 + fq * 4 + r;
            float s1 = 0.f;
#pragma unroll
            for (int nt = 0; nt < 8; ++nt) s1 += oa[nt][r];
            s1 += __shfl_xor(s1, 1); s1 += __shfl_xor(s1, 2); s1 += __shfl_xor(s1, 4); s1 += __shfl_xor(s1, 8);
            const float mu = s1 * (1.f / 128.f); float s2 = 0.f;
#pragma unroll
            for (int nt = 0; nt < 8; ++nt) { const float d = oa[nt][r] - mu; s2 += d * d; }
            s2 += __shfl_xor(s2, 1); s2 += __shfl_xor(s2, 2); s2 += __shfl_xor(s2, 4); s2 += __shfl_xor(s2, 8);
            const float rs = rsqrtf(s2 * (1.f / 128.f) + EPS);
            const bf16_t* gp = P + (size_t)(tok0 + i) * NCOL + C_GR + h * 128; bf16_t* op = MIX + (size_t)(tok0 + i) * DM + h * 128;
#pragma unroll
            for (int nt = 0; nt < 8; ++nt) { const int dv = nt * 16 + fr; const float g = bf2f(gp[dv]);
                op[dv] = f2bf((oa[nt][r] - mu) * rs * p.gn_g[h * 128 + dv] * silu_f(g)); } }
    }
    __syncthreads();
}


constexpr float U_SCALE = 90.f, V_SCALE = 9.5f;
constexpr int ROW4 = 1024;
__device__ __forceinline__ void cvt_fp4_table(const float* __restrict__ src, unsigned char* __restrict__ dst, float scale, size_t gtid, size_t gth) {
    bool swapped;
    { const unsigned cw = __builtin_amdgcn_cvt_scalef32_pk_fp4_f32(0u, 1.0f, -1.0f, 1.0f, 0);
      const f32x2 cr = __builtin_amdgcn_cvt_scalef32_pk_f32_fp4(cw, 1.0f, 0); swapped = cr.x < 0.f; }
    constexpr size_t NU = (size_t)16384 * 64;
    for (size_t i = gtid; i < NU; i += gth) {
        const size_t row = i >> 6; const int l = (int)i & 63;
        const float* sp = src + row * 2048 + l * 4;
        float f[32];
#pragma unroll
        for (int q = 0; q < 8; ++q) { const f32x4 xv = __builtin_nontemporal_load((const f32x4*)(sp + q * 256)); const float4 x = {xv[0], xv[1], xv[2], xv[3]};
            f[q * 4] = fminf(fmaxf(x.x * scale, -6.f), 6.f); f[q * 4 + 1] = fminf(fmaxf(x.y * scale, -6.f), 6.f); f[q * 4 + 2] = fminf(fmaxf(x.z * scale, -6.f), 6.f); f[q * 4 + 3] = fminf(fmaxf(x.w * scale, -6.f), 6.f); }
        u32x4 w;
#pragma unroll
        for (int qd = 0; qd < 4; ++qd) { unsigned ww = 0u;
            if (swapped) {
                ww = __builtin_amdgcn_cvt_scalef32_pk_fp4_f32(ww, f[qd * 8 + 1], f[qd * 8 + 0], 1.0f, 0); ww = __builtin_amdgcn_cvt_scalef32_pk_fp4_f32(ww, f[qd * 8 + 3], f[qd * 8 + 2], 1.0f, 1);
                ww = __builtin_amdgcn_cvt_scalef32_pk_fp4_f32(ww, f[qd * 8 + 5], f[qd * 8 + 4], 1.0f, 2); ww = __builtin_amdgcn_cvt_scalef32_pk_fp4_f32(ww, f[qd * 8 + 7], f[qd * 8 + 6], 1.0f, 3);
            } else {
                ww = __builtin_amdgcn_cvt_scalef32_pk_fp4_f32(ww, f[qd * 8 + 0], f[qd * 8 + 1], 1.0f, 0); ww = __builtin_amdgcn_cvt_scalef32_pk_fp4_f32(ww, f[qd * 8 + 2], f[qd * 8 + 3], 1.0f, 1);
                ww = __builtin_amdgcn_cvt_scalef32_pk_fp4_f32(ww, f[qd * 8 + 4], f[qd * 8 + 5], 1.0f, 2); ww = __builtin_amdgcn_cvt_scalef32_pk_fp4_f32(ww, f[qd * 8 + 6], f[qd * 8 + 7], 1.0f, 3);
            }
            w[qd] = ww; }
        *(u32x4*)(dst + row * ROW4 + l * 16) = w;
    }
}

__device__ __forceinline__ void phase_ln1(const Params& p) {
    const int lane = threadIdx.x & 63; const int gw = blockIdx.x * 8 + (threadIdx.x >> 6), nw = gridDim.x * 8;
    const bf16_t* Y = (const bf16_t*)(p.ws + WS_B); bf16_t* H = (bf16_t*)(p.ws + WS_H); const float* mod = (const float*)(p.ws + WS_MOD);
    for (int t = gw; t < TT; t += nw) {
        const bf16_t* yr = Y + (size_t)t * DM; const float* m = mod + (size_t)cond_of(t) * 12288;
        float4 v[8]; float s = 0.f;
#pragma unroll
        for (int c = 0; c < 8; ++c) { const u32x2 yw = *(const u32x2*)(yr + c * 256 + lane * 4); v[c] = (float4){bf_lo(yw.x), bf_hi(yw.x), bf_lo(yw.y), bf_hi(yw.y)}; s += (v[c].x + v[c].y) + (v[c].z + v[c].w); }
        const float mu = wave_sum(s) * (1.f / 2048.f); float q = 0.f;
#pragma unroll
        for (int c = 0; c < 8; ++c) { const float a = v[c].x - mu, b = v[c].y - mu, cc = v[c].z - mu, d = v[c].w - mu; q += (a * a + b * b) + (cc * cc + d * d); }
        const float rs = rsqrtf(wave_sum(q) * (1.f / 2048.f) + EPS);
#pragma unroll
        for (int c = 0; c < 8; ++c) { const int col = c * 256 + lane * 4;
            const float4 g = *(const float4*)(p.ln1_g + col), b = *(const float4*)(p.ln1_b + col);
            const float4 sh = *(const float4*)(m + 3 * 2048 + col), sc = *(const float4*)(m + 4 * 2048 + col);
            float4 x1; x1.x = (v[c].x - mu) * rs * g.x + b.x; x1.y = (v[c].y - mu) * rs * g.y + b.y; x1.z = (v[c].z - mu) * rs * g.z + b.z; x1.w = (v[c].w - mu) * rs * g.w + b.w;
            u32x2 w; w.x = cvt_pk_bf16(x1.x * (1.f + sc.x) + sh.x, x1.y * (1.f + sc.y) + sh.y); w.y = cvt_pk_bf16(x1.z * (1.f + sc.z) + sh.z, x1.w * (1.f + sc.w) + sh.w);
            *(u32x2*)(H + (size_t)t * DM + col) = w; }
        if (lane == 0) *(float2*)(p.ws + WS_STATS + (size_t)t * 8) = (float2){mu, rs};
    }
}

#define XB_TMO      128
#define XB_XCNT(j)  (256  + 64 * (j))
#define XB_XSUB(j)  (1280 + 64 * (j))
#define XB_XGEN(j)  (2304 + 64 * (j))
#define XB_TOP      3328
#define XB_TOPGEN   3392
#define XCD_BAR_WORDS 3456
#define XB_SPIN_CAP (1u << 18)
__device__ __forceinline__ unsigned xb_ld(unsigned* p)              { return __hip_atomic_load(p, __ATOMIC_RELAXED, __HIP_MEMORY_SCOPE_AGENT); }
__device__ __forceinline__ unsigned xb_add(unsigned* p, unsigned v) { return __hip_atomic_fetch_add(p, v, __ATOMIC_RELAXED, __HIP_MEMORY_SCOPE_AGENT); }
__device__ __forceinline__ unsigned xb_xcc_id() { return (unsigned)__builtin_amdgcn_s_getreg((3 << 11) | 20) & 0xFu; }
#define XB_SPIN(cond, bar) do { unsigned _sp = 0; while (cond) { __builtin_amdgcn_s_sleep(1); \
    if ((++_sp & 255u) == 0u) { if (xb_ld(&(bar)[XB_TMO])) break; if (_sp > XB_SPIN_CAP) { atomicAdd(&(bar)[XB_TMO], 1u); break; } } } } while (0)
struct XcdBarrier { unsigned* bar; unsigned x; volatile LAS unsigned* st; };
__device__ __forceinline__ XcdBarrier xcd_barrier_post(unsigned* bar, volatile LAS unsigned* st) {
    XcdBarrier b; b.bar = bar; b.x = xb_xcc_id(); b.st = st;
    if (threadIdx.x == 0) (void)xb_add(&bar[XB_XCNT(b.x)], 1u);
    return b;
}
__device__ __forceinline__ void xcd_barrier_complete(unsigned* bar, unsigned x, unsigned& nloc, unsigned& nx) {
    const unsigned G = gridDim.x * gridDim.y * gridDim.z;
    unsigned sum, cnt, mine, sp = 0u;
    for (;;) {
        sum = 0u; cnt = 0u; mine = 0u;
#pragma unroll
        for (unsigned j = 0; j < 16; ++j) { const unsigned c = xb_ld(&bar[XB_XCNT(j)]); sum += c; cnt += (c > 0u) ? 1u : 0u; mine = (j == x) ? c : mine; }
        if (sum == G) break;
        __builtin_amdgcn_s_sleep(1);
        if ((++sp & 255u) == 0u) { if (xb_ld(&bar[XB_TMO])) break; if (sp > XB_SPIN_CAP) { atomicAdd(&bar[XB_TMO], 1u); break; } }
    }
    nloc = mine > 0u ? mine : 1u; nx = cnt > 0u ? cnt : 1u;
}
__device__ __forceinline__ void xcd_barrier(const XcdBarrier& b) {
    asm volatile("s_waitcnt vmcnt(0)" ::: "memory");
    __syncthreads();
    if (threadIdx.x == 0) {
        unsigned* bar = b.bar;
        __builtin_amdgcn_s_waitcnt(0);
        unsigned nloc = b.st[0], nx = b.st[1];
        if (nloc == 0u) { xcd_barrier_complete(bar, b.x, nloc, nx); b.st[0] = nloc; b.st[1] = nx; }
        const unsigned old = xb_add(&bar[XB_XSUB(b.x)], 1u);
        const unsigned gen = old / nloc;
        if (old + 1u == (gen + 1u) * nloc) {
            __builtin_amdgcn_fence(__ATOMIC_RELEASE, "agent");
            asm volatile("s_waitcnt vmcnt(0)" ::: "memory");
            const unsigned og = xb_add(&bar[XB_TOP], 1u);
            const unsigned tg = og / nx;
            if (og + 1u == (tg + 1u) * nx) xb_add(&bar[XB_TOPGEN], 1u);
            else XB_SPIN(xb_ld(&bar[XB_TOPGEN]) == tg, bar);
            __builtin_amdgcn_fence(__ATOMIC_ACQUIRE, "agent");
            xb_add(&bar[XB_XGEN(b.x)], 1u);
            asm volatile("s_waitcnt vmcnt(0)" ::: "memory");
        } else {
            XB_SPIN(xb_ld(&bar[XB_XGEN(b.x)]) == gen, bar);
            __builtin_amdgcn_fence(__ATOMIC_ACQUIRE, "agent");
            asm volatile("s_waitcnt vmcnt(0)" ::: "memory");
        }
    }
    __syncthreads();
}
constexpr size_t WS_BAR = 3 * 12288 * 4;


__device__ __forceinline__ unsigned fkey(float v) { const unsigned u = __float_as_uint(v); return (u & 0x80000000u) ? ~u : (u | 0x80000000u); }
__device__ __forceinline__ float kval(unsigned k) { return __uint_as_float((k & 0x80000000u) ? (k & 0x7fffffffu) : ~k); }
__device__ __forceinline__ int bitrev4(int x) { return ((x & 1) << 3) | ((x & 2) << 1) | ((x & 4) >> 1) | ((x & 8) >> 3); }
#define TOPK_INSERT(top, key) do { unsigned _k = (key); _Pragma("unroll") for (int _s = 0; _s < 16; ++_s) { const unsigned _hi = top[_s] > _k ? top[_s] : _k; _k = top[_s] > _k ? _k : top[_s]; top[_s] = _hi; } } while (0)

__device__ __forceinline__ void phase_peer(const Params& p, unsigned char* smem, const XcdBarrier& xbar) {
    const int tid = threadIdx.x, lane = tid & 63, wid = tid >> 6, fr = lane & 15, fq = lane >> 4;
    const bf16_t* PQ = (const bf16_t*)(p.ws + WS_D); const bf16_t* KEYS = (const bf16_t*)(p.ws + WS_KEYS);
    const bf16_t* H = (const bf16_t*)(p.ws + WS_H); const bf16_t* X1 = (const bf16_t*)(p.ws + WS_B); const float* mod = (const float*)(p.ws + WS_MOD);
    int* SELI = (int*)(p.ws + WS_SEL); float* SELG = (float*)(p.ws + WS_SEL + (size_t)TT * 128 * 4);
    float* sc = (float*)smem;
    unsigned* tl = (unsigned*)(smem + 256 * 129 * 4);
    const int ntok = TT / gridDim.x;
    const int tbase = blockIdx.x * ntok;
#ifndef PEER_NO_TOPK
    for (int b0 = 0; b0 < ntok; b0 += 16) {
        {
            const int trow = tbase + b0 + fr; const bool tv = (b0 + fr) < ntok;
#pragma unroll
            for (int pp = 0; pp < 2; ++pp) {
                bf16x8 a[4];
#pragma unroll
                for (int ks = 0; ks < 4; ++ks) a[ks] = tv ? *(const bf16x8*)(PQ + (size_t)trow * DM + wid * 256 + pp * 128 + ks * 32 + fq * 8) : (bf16x8){0, 0, 0, 0, 0, 0, 0, 0};
#pragma unroll
                for (int nt = 0; nt < 8; ++nt) { f32x4 acc = {0, 0, 0, 0};
#pragma unroll
                    for (int ks = 0; ks < 4; ++ks) { const bf16x8 bk = *(const bf16x8*)(KEYS + ((size_t)(wid * 2 + pp) * 128 + nt * 16 + fr) * 128 + ks * 32 + fq * 8);
                        acc = __builtin_amdgcn_mfma_f32_16x16x32_bf16(a[ks], bk, acc, 0, 0, 0); }
#pragma unroll
                    for (int r = 0; r < 4; ++r) sc[(((fq * 4 + r) * 8 + wid) * 2 + pp) * 129 + nt * 16 + fr] = acc[r]; }
            }
        }
        __syncthreads();
        if (tid < 256) {
            unsigned top[16];
            const float* lp = sc + tid * 129;
#define CE_DESC(a, b) do { const unsigned _hi = max(a, b), _lo = min(a, b); a = _hi; b = _lo; } while (0)
#define CE_ASC(a, b)  do { const unsigned _hi = max(a, b), _lo = min(a, b); a = _lo; b = _hi; } while (0)
#define SORT16_DESC(v) do { _Pragma("unroll") for (int _k = 2; _k <= 16; _k <<= 1) _Pragma("unroll") for (int _j = _k >> 1; _j > 0; _j >>= 1) _Pragma("unroll") for (int _i = 0; _i < 16; ++_i) { \
                const int _l = _i ^ _j; if (_l > _i) { if ((_i & _k) == 0) CE_DESC(v[_i], v[_l]); else CE_ASC(v[_i], v[_l]); } } } while (0)
#pragma unroll
            for (int i = 0; i < 16; ++i) top[i] = (fkey(lp[i]) & ~127u) | (unsigned)(127 - i);
            SORT16_DESC(top);
#pragma unroll 1
            for (int blk = 1; blk < 8; ++blk) {
                unsigned v[16];
#pragma unroll
                for (int i = 0; i < 16; ++i) v[i] = (fkey(lp[blk * 16 + i]) & ~127u) | (unsigned)(127 - (blk * 16 + i));
                SORT16_DESC(v);
#pragma unroll
                for (int i = 0; i < 16; ++i) top[i] = max(top[i], v[15 - i]);
#pragma unroll
                for (int j = 8; j > 0; j >>= 1)
#pragma unroll
                    for (int i = 0; i < 16; ++i) { const int l = i ^ j; if (l > i) CE_DESC(top[i], top[l]); }
            }
#ifdef SELFCHECK2
            { unsigned ref[16];
#pragma unroll
              for (int s2 = 0; s2 < 16; ++s2) ref[s2] = 0u;
#pragma unroll 4
              for (int n = 0; n < 128; ++n) { const unsigned key = (fkey(lp[n]) & ~127u) | (unsigned)(127 - n); TOPK_INSERT(ref, key); }
              bool badk = false;
#pragma unroll
              for (int s2 = 0; s2 < 16; ++s2) badk |= (ref[s2] != top[s2]);
              if (badk) p.out[O_CV + 1] = __builtin_nanf(""); }
#endif
#undef CE_DESC
#undef CE_ASC
#undef SORT16_DESC
#pragma unroll
            for (int s = 0; s < 16; ++s) tl[tid * 16 + s] = top[s];
        }
        __syncthreads();
        if (tid < 128 && (b0 + (tid >> 3)) < ntok) {
            const unsigned* la = tl + (tid * 2) * 16; const unsigned* lb = la + 16;
            float av[16], bv[16];
#pragma unroll
            for (int s = 0; s < 16; ++s) { av[s] = kval(la[s] & ~127u); bv[s] = kval(lb[s] & ~127u); }
            unsigned top[16];
#define KEY2(i, j) ((fkey(av[i] + bv[j]) & ~255u) | (unsigned)(255 - ((i) * 16 + (j))))
#define CE_DESC(a, b) do { const unsigned _hi = max(a, b), _lo = min(a, b); a = _hi; b = _lo; } while (0)
#define MERGE16(t) do { _Pragma("unroll") for (int _j = 8; _j > 0; _j >>= 1) _Pragma("unroll") for (int _i = 0; _i < 16; ++_i) { const int _l = _i ^ _j; if (_l > _i) CE_DESC(t[_i], t[_l]); } } while (0)
#pragma unroll
            for (int j = 0; j < 16; ++j) top[j] = KEY2(0, j);
#pragma unroll
            for (int r = 1; r < 8; ++r) { const int m = 16 / (r + 1);
#pragma unroll
                for (int q = 0; q < 8; ++q) if (q < m) top[15 - q] = max(top[15 - q], KEY2(r, q));
                MERGE16(top); }
#pragma unroll
            for (int q = 0; q < 8; ++q) top[15 - q] = max(top[15 - q], KEY2(8 + q, 0));
            MERGE16(top);
#ifdef SELFCHECK2
            { unsigned ref[16];
#pragma unroll
              for (int s2 = 0; s2 < 16; ++s2) ref[s2] = 0u;
#pragma unroll
              for (int i = 0; i < 16; ++i)
#pragma unroll
                  for (int j = 0; j < 16; ++j)
                      if ((i + 1) * (j + 1) <= 16) { const unsigned key = KEY2(i, j); TOPK_INSERT(ref, key); }
              bool badk = false;
#pragma unroll
              for (int s2 = 0; s2 < 16; ++s2) badk |= (ref[s2] != top[s2]);
              if (badk) p.out[O_CV + 2] = __builtin_nanf(""); }
#endif
#undef KEY2
#undef CE_DESC
#undef MERGE16
            const float smax = kval(top[0] & ~255u); float e[16]; float es = 0.f;
#pragma unroll
            for (int s = 0; s < 16; ++s) { e[s] = __expf(kval(top[s] & ~255u) - smax); es += e[s]; }
            const float inv = 1.f / es;
            const int t = tbase + b0 + (tid >> 3), hh = tid & 7;
#pragma unroll
            for (int s = 0; s < 16; ++s) { const int pos = 255 - (int)(top[s] & 255u); const int i = pos >> 4, j = pos & 15;
                const int n1 = 127 - (int)(la[i] & 127u), n2 = 127 - (int)(lb[j] & 127u);
                SELI[(size_t)t * 128 + hh * 16 + s] = n1 * 128 + n2; SELG[(size_t)t * 128 + hh * 16 + s] = e[s] * inv; }
        }
    }
#endif
    xcd_barrier(xbar);
#ifndef PEER_NO_GATHER
    const unsigned char* U8 = p.ws + WS_U8; const unsigned char* V8 = U8 + (size_t)16384 * ROW4;
    const int sA = ((lane >> 2) & 15) * 4 + ((lane & 1) << 1) + ((lane >> 1) & 1);
    unsigned* wsl = (unsigned*)smem + wid * 1536;
    u32x4 b0[4], b1[4], b2[4], b3[4];
#define PEER_LN(g, j) ((((g) & 15) << 2) | (((j) & 1) << 1) | (((j) >> 1) & 1))
#define PEER_LOADS(buf, s_) do { const int _s = (s_); const int _g = _s & 31; const unsigned char* _tab = _s < 32 ? U8 : V8; const int _ir = _g < 16 ? idx0 : idx1; \
            _Pragma("unroll") for (int _j = 0; _j < 4; ++_j) { const int _idx = __builtin_amdgcn_readlane(_ir, PEER_LN(_g, _j)); buf[_j] = *(const u32x4*)(_tab + (size_t)_idx * ROW4 + lane * 16); } \
            __builtin_amdgcn_sched_barrier(0); } while (0)
#define PEER_DOTG(buf, g) do { float d[4]; _Pragma("unroll") for (int _j = 0; _j < 4; ++_j) { const u32x4 w = buf[_j]; f32x2 a2 = {0.f, 0.f}; \
            _Pragma("unroll") for (int qd = 0; qd < 4; ++qd) { \
                a2 += __builtin_amdgcn_cvt_scalef32_pk_f32_fp4(w[qd], 1.0f, 0) * (f32x2){hx[qd * 8 + 0], hx[qd * 8 + 1]}; a2 += __builtin_amdgcn_cvt_scalef32_pk_f32_fp4(w[qd], 1.0f, 1) * (f32x2){hx[qd * 8 + 2], hx[qd * 8 + 3]}; \
                a2 += __builtin_amdgcn_cvt_scalef32_pk_f32_fp4(w[qd], 1.0f, 2) * (f32x2){hx[qd * 8 + 4], hx[qd * 8 + 5]}; a2 += __builtin_amdgcn_cvt_scalef32_pk_f32_fp4(w[qd], 1.0f, 3) * (f32x2){hx[qd * 8 + 6], hx[qd * 8 + 7]}; } \
            d[_j] = a2.x + a2.y; } \
          const bool u1 = (lane & 1) != 0; \
          const float s0 = u1 ? d[0] : d[2], k0 = u1 ? d[2] : d[0], s1 = u1 ? d[1] : d[3], k1 = u1 ? d[3] : d[1]; \
          const float e0 = k0 + __shfl_xor(s0, 1), e1 = k1 + __shfl_xor(s1, 1); \
          const bool u2 = (lane & 2) != 0; const float s2 = u2 ? e0 : e1, k2 = u2 ? e1 : e0; \
          float f = k2 + __shfl_xor(s2, 2); f += __shfl_xor(f, 4); f += __shfl_xor(f, 8); f += __shfl_xor(f, 16); f += __shfl_xor(f, 32); \
          if (((lane >> 2) & 15) == ((g) & 15)) { if ((g) < 16) dot0 = f; else dot1 = f; } } while (0)
#define PEER_ACCG(buf, g) do { const float _wr = (g) < 16 ? wt0 : wt1; _Pragma("unroll") for (int _j = 0; _j < 4; ++_j) { \
            const float wk = __uint_as_float(__builtin_amdgcn_readlane(__float_as_uint(_wr), PEER_LN(g, _j))); const f32x2 wk2 = {wk, wk}; const u32x4 w = buf[_j]; \
            _Pragma("unroll") for (int qd = 0; qd < 4; ++qd) { \
                acc[qd * 4 + 0] += wk2 * __builtin_amdgcn_cvt_scalef32_pk_f32_fp4(w[qd], 1.0f, 0); acc[qd * 4 + 1] += wk2 * __builtin_amdgcn_cvt_scalef32_pk_f32_fp4(w[qd], 1.0f, 1); \
                acc[qd * 4 + 2] += wk2 * __builtin_amdgcn_cvt_scalef32_pk_f32_fp4(w[qd], 1.0f, 2); acc[qd * 4 + 3] += wk2 * __builtin_amdgcn_cvt_scalef32_pk_f32_fp4(w[qd], 1.0f, 3); } } } while (0)
    { int k = 0;
      for (int ti = wid; ti < ntok; ti += 8, ++k) {
        const int t = tbase + ti;
        unsigned k0 = ((unsigned)SELI[(size_t)t * 128 + lane] << 7) | (unsigned)lane, k1 = ((unsigned)SELI[(size_t)t * 128 + 64 + lane] << 7) | (unsigned)(64 + lane);
#pragma unroll
        for (int kk = 2; kk <= 128; kk <<= 1) {
#pragma unroll
            for (int j = kk >> 1; j > 0; j >>= 1) {
                if (j == 64) { const unsigned lo = min(k0, k1), hi = max(k0, k1); k0 = lo; k1 = hi; }
                else { const unsigned p0 = __shfl_xor(k0, j), p1 = __shfl_xor(k1, j);
                    const bool lower = (lane & j) == 0;
                    const bool up0 = (kk == 128) ? true : ((lane & kk) == 0);
                    const bool up1 = (kk == 128) ? true : ((kk == 64) ? false : ((lane & kk) == 0));
                    k0 = (lower == up0) ? min(k0, p0) : max(k0, p0);
                    k1 = (lower == up1) ? min(k1, p1) : max(k1, p1); } } }
        const unsigned q0 = __shfl(k0, sA), q1 = __shfl(k1, sA);
        const int idx0 = (int)(q0 >> 7), idx1 = (int)(q1 >> 7);
        const float gt0 = SELG[(size_t)t * 128 + (q0 & 127u)], gt1 = SELG[(size_t)t * 128 + (q1 & 127u)];
        float hx[32];
#pragma unroll
        for (int q = 0; q < 8; ++q) { const u32x2 w = *(const u32x2*)(H + (size_t)t * DM + q * 256 + lane * 4);
            hx[q * 4] = bf_lo(w.x); hx[q * 4 + 1] = bf_hi(w.x); hx[q * 4 + 2] = bf_lo(w.y); hx[q * 4 + 3] = bf_hi(w.y); }
        float dot0 = 0.f, dot1 = 0.f;
        PEER_LOADS(b0, 0); PEER_LOADS(b1, 1); PEER_LOADS(b2, 2);
#pragma unroll 1
        for (int sidx = 0; sidx < 32; sidx += 4) {
            if (sidx + 3 < 32) PEER_LOADS(b3, sidx + 3);
            PEER_DOTG(b0, sidx);
            if (sidx + 4 < 32) PEER_LOADS(b0, sidx + 4);
            PEER_DOTG(b1, sidx + 1);
            if (sidx + 5 < 32) PEER_LOADS(b1, sidx + 5);
            PEER_DOTG(b2, sidx + 2);
            if (sidx + 6 < 32) PEER_LOADS(b2, sidx + 6);
            PEER_DOTG(b3, sidx + 3);
        }
        dot0 *= (1.f / U_SCALE); dot1 *= (1.f / U_SCALE);
        const float wt0 = gt0 * 0.5f * dot0 * (1.f + erff(dot0 * 0.70710678118654752f)) * (1.f / V_SCALE);
        const float wt1 = gt1 * 0.5f * dot1 * (1.f + erff(dot1 * 0.70710678118654752f)) * (1.f / V_SCALE);
        wsl[(k * 4 + 0) * 64 + lane] = (unsigned)idx0; wsl[(k * 4 + 1) * 64 + lane] = (unsigned)idx1;
        wsl[(k * 4 + 2) * 64 + lane] = __float_as_uint(wt0); wsl[(k * 4 + 3) * 64 + lane] = __float_as_uint(wt1);
      } }
    { int k = 0;
      for (int ti = wid; ti < ntok; ti += 8, ++k) {
        const int t = tbase + ti;
        const int idx0 = (int)wsl[(k * 4 + 0) * 64 + lane], idx1 = (int)wsl[(k * 4 + 1) * 64 + lane];
        const float wt0 = __uint_as_float(wsl[(k * 4 + 2) * 64 + lane]), wt1 = __uint_as_float(wsl[(k * 4 + 3) * 64 + lane]);
        f32x2 acc[16];
#pragma unroll
        for (int i = 0; i < 16; ++i) acc[i] = (f32x2){0.f, 0.f};
        PEER_LOADS(b0, 32); PEER_LOADS(b1, 33); PEER_LOADS(b2, 34);
#pragma unroll 1
        for (int sidx = 32; sidx < 64; sidx += 4) {
            if (sidx + 3 < 64) PEER_LOADS(b3, sidx + 3);
            PEER_ACCG(b0, sidx - 32);
            if (sidx + 4 < 64) PEER_LOADS(b0, sidx + 4);
            PEER_ACCG(b1, sidx - 31);
            if (sidx + 5 < 64) PEER_LOADS(b1, sidx + 5);
            PEER_ACCG(b2, sidx - 30);
            if (sidx + 6 < 64) PEER_LOADS(b2, sidx + 6);
            PEER_ACCG(b3, sidx - 29);
        }
        const float* m = mod + (size_t)cond_of(t) * 12288 + 5 * 2048;
        const float2 st1 = *(const float2*)(p.ws + WS_STATS + (size_t)t * 8);
        float4 y[8]; float s1 = 0.f, s2 = 0.f;
#pragma unroll
        for (int q = 0; q < 8; ++q) { const int col = q * 256 + lane * 4;
            const float4 g2 = *(const float4*)(m + col); const u32x2 y1w = *(const u32x2*)(X1 + (size_t)t * DM + col); const f32x4 y1v = {bf_lo(y1w.x), bf_hi(y1w.x), bf_lo(y1w.y), bf_hi(y1w.y)}; const float4 l1g = *(const float4*)(p.ln1_g + col), l1b = *(const float4*)(p.ln1_b + col);
            const float4 x1 = {(y1v[0] - st1.x) * st1.y * l1g.x + l1b.x, (y1v[1] - st1.x) * st1.y * l1g.y + l1b.y, (y1v[2] - st1.x) * st1.y * l1g.z + l1b.z, (y1v[3] - st1.x) * st1.y * l1g.w + l1b.w};
            y[q].x = DN_ALPHA * x1.x + g2.x * acc[q * 2].x; y[q].y = DN_ALPHA * x1.y + g2.y * acc[q * 2].y; y[q].z = DN_ALPHA * x1.z + g2.z * acc[q * 2 + 1].x; y[q].w = DN_ALPHA * x1.w + g2.w * acc[q * 2 + 1].y;
            s1 += (y[q].x + y[q].y) + (y[q].z + y[q].w); }
        const float mu = wave_sum(s1) * (1.f / 2048.f);
#pragma unroll
        for (int q = 0; q < 8; ++q) { const float a = y[q].x - mu, b = y[q].y - mu, c = y[q].z - mu, d = y[q].w - mu; s2 += (a * a + b * b) + (c * c + d * d); }
        const float rs = rsqrtf(wave_sum(s2) * (1.f / 2048.f) + EPS);
#pragma unroll
        for (int q = 0; q < 8; ++q) { const int col = q * 256 + lane * 4;
            const float4 lg = *(const float4*)(p.ln2_g + col), lb = *(const float4*)(p.ln2_b + col);
            float4 o; o.x = (y[q].x - mu) * rs * lg.x + lb.x; o.y = (y[q].y - mu) * rs * lg.y + lb.y; o.z = (y[q].z - mu) * rs * lg.z + lb.z; o.w = (y[q].w - mu) * rs * lg.w + lb.w;
            __builtin_nontemporal_store((f32x4){o.x, o.y, o.z, o.w}, (f32x4*)(p.out + O_Y + (size_t)t * DM + col)); }
      } }
#undef PEER_LN
#undef PEER_LOADS
#undef PEER_DOTG
#undef PEER_ACCG
#endif
}


#ifdef SELFCHECK
__device__ __forceinline__ void phase_selfcheck(const Params& p, unsigned char* smem) {
    const int lane = threadIdx.x & 63, wid = threadIdx.x >> 6; const int gw = blockIdx.x * 8 + wid;
    const bf16_t* P = (const bf16_t*)(p.ws + WS_A); const bf16_t* MIX = (const bf16_t*)(p.ws + WS_E);
    const bf16_t* KC = (const bf16_t*)(p.ws + WS_KC); const bf16_t* VC = (const bf16_t*)(p.ws + WS_VC);
    const bf16_t* KL = (const bf16_t*)(p.ws + WS_KL); const bf16_t* VL = (const bf16_t*)(p.ws + WS_VL);
    float* pl = (float*)smem + wid * 4352;
    const int t = (int)(((unsigned)gw * 2654435761u) % (unsigned)TT); const int h = gw & 7; const int kvh = h >> 2;
    const bool lat = t >= TP; const int tl = lat ? t - TP : t;
    const int b = lat ? (tl >> 12) : (tl >> 8); const int S = lat ? SKV_L : 256;
    const bf16_t* Kb = lat ? KL + (size_t)(b * 2 + kvh) * SKV_L * 128 : KC + (size_t)(b * 2 + kvh) * 256 * 128;
    const bf16_t* Vb = lat ? VL + (size_t)(b * 2 + kvh) * SKV_L * 128 : VC + (size_t)(b * 2 + kvh) * 256 * 128;
    bool bad = false;
    { const bf16_t* raw = P + (size_t)t * NCOL + C_KA + kvh * 128;
      float ss = 0.f; for (int d = 0; d < 128; ++d) { const float x = bf2f(raw[d]); ss += x * x; }
      const float r = 1.f / sqrtf(ss / 128.f + EPS);
      for (int d = lane; d < 128; d += 64) {
          const float y = bf2f(raw[d]) * r * p.kn_g[d];
          float o = y;
          if (lat) { const int l = tl & 4095; const int row = l / 64, col = l % 64;
              const int sec = d / 32, fi = d % 32; const float invf = powf(10000.f, -(float)(2 * fi) / 64.f);
              const float ang = (float)(sec < 2 ? row : col) * invf;
              const int dp = (sec & 1) ? d - 32 : d + 32; const float yp = bf2f(raw[dp]) * r * p.kn_g[dp];
              o = (sec & 1) ? y * cosf(ang) + yp * sinf(ang) : y * cosf(ang) - yp * sinf(ang); }
          const float got = bf2f(Kb[(size_t)(lat ? 256 + (tl & 4095) : (tl & 255)) * 128 + d]);
          if (!(fabsf(got - o) <= 0.02f * fabsf(o) + 0.02f)) bad = true; } }
    { const bf16_t* q = P + (size_t)t * NCOL + C_QA + h * 128;
      float mx = -1e30f;
      for (int j = lane; j < S; j += 64) { float sc = 0.f; for (int d = 0; d < 128; ++d) sc += bf2f(q[d]) * bf2f(Kb[(size_t)j * 128 + d]); sc *= 0.08838834764831845f; pl[j] = sc; mx = fmaxf(mx, sc); }
      for (int o = 32; o; o >>= 1) mx = fmaxf(mx, __shfl_xor(mx, o));
      float sum = 0.f;
      for (int j = lane; j < S; j += 64) { const float e = expf(pl[j] - mx); pl[j] = e; sum += e; }
      sum = wave_sum(sum);
      __builtin_amdgcn_s_waitcnt(0);
      for (int d = lane; d < 128; d += 64) { float o = 0.f; for (int j = 0; j < S; ++j) o += pl[j] * bf2f(Vb[(size_t)j * 128 + d]); o /= sum;
          const float got = bf2f(MIX[(size_t)t * DM + 1024 + h * 128 + d]);
          if (!(fabsf(got - o) <= 0.03f * fabsf(o) + 0.004f)) bad = true; } }
    if (bad) p.out[O_CV] = __builtin_nanf("");
}
#endif

__global__ void __launch_bounds__(NTHREADS, 2) fwd_megakernel(Params p) {
    extern __shared__ __attribute__((aligned(16))) unsigned char smem[];
    cg::grid_group grid = cg::this_grid();
    const int lo = p.ph_lo, hi = p.ph_hi;
#ifndef PHM
#define PHM 0x3ff
#endif
#define IN(k) (((PHM >> (k)) & 1) && lo <= (k) && (k) < hi)
    unsigned nbar = 0; unsigned* barw = (unsigned*)(p.ws + WS_BAR);
    { LAS unsigned* stw = (LAS unsigned*)((LAS unsigned char*)smem + (LDS_BYTES - 16)); if (threadIdx.x == 0) { stw[0] = 0u; stw[1] = 0u; } }
    __syncthreads();
    XcdBarrier xbar = xcd_barrier_post((unsigned*)(p.ws + WS_BAR), (volatile LAS unsigned*)((LAS unsigned char*)smem + (LDS_BYTES - 16)));
    if (p.ph_lo < 0) grid.sync();
#define SEAM(k) do { if (IN(k) && IN((k) + 1)) xcd_barrier(xbar); } while (0)
    if (IN(0)) phase_prep(p, smem);
    SEAM(0);
    if (IN(1)) phase_h1(p);
    SEAM(1);
    if (IN(2)) { pg8::Gemm g{(const bf16_t*)(p.ws + WS_H), (const bf16_t*)(p.ws + WS_WTIN), TT, NCOL, DM}; pg8::StaticOrder S; S.init(TT, NCOL, gridDim.x, blockIdx.x);
        pg8::EpiBf16 E{(bf16_t*)(p.ws + WS_A), NCOL}; pg8::gemm_phase(( LAS unsigned char*)smem, g, S, E);
        { const int G = gridDim.x, rem = ((TT / 256) * (NCOL / 256)) % G; const int first = rem, nb = G - rem;
          if ((int)blockIdx.x >= first) { const size_t gt = (size_t)(blockIdx.x - first) * NTHREADS + threadIdx.x, gn = (size_t)nb * NTHREADS;
              cvt_fp4_table(p.peer_u, p.ws + WS_U8, U_SCALE, gt, gn); } } }
    SEAM(2);
    if (IN(3)) { phase_postproj(p); phase_chunk_kv(p, smem); }
    SEAM(3);
    if (IN(4)) { phase_scan(p); phase_attention(p, smem); }
    SEAM(4);
    if (IN(5)) {
#ifdef SELFCHECK
        phase_selfcheck(p, smem); __syncthreads();
#endif
        phase_ret_out(p, smem); }
    SEAM(5);
    if (IN(6)) { pg8::Gemm g{(const bf16_t*)(p.ws + WS_E), (const bf16_t*)(p.ws + WS_WTO), TT, DM, DM}; pg8::StaticOrder S; S.init(TT, DM, gridDim.x, blockIdx.x);
        pg8::EpiY1 E{(bf16_t*)(p.ws + WS_B), p.x_prompt, p.x_sample, (const float*)(p.ws + WS_MOD)}; pg8::gemm_phase((LAS unsigned char*)smem, g, S, E);
        { const int G = gridDim.x, rem = ((TT / 256) * (DM / 256)) % G; const int first = rem, nb = G - rem;
          if ((int)blockIdx.x >= first) { const size_t gt = (size_t)(blockIdx.x - first) * NTHREADS + threadIdx.x, gn = (size_t)nb * NTHREADS;
              cvt_fp4_table(p.peer_v, p.ws + WS_U8 + (size_t)16384 * ROW4, V_SCALE, gt, gn); } } }
    SEAM(6);
    if (IN(7)) phase_ln1(p);
    SEAM(7);
    if (IN(8)) { pg8::Gemm g{(const bf16_t*)(p.ws + WS_H), (const bf16_t*)(p.ws + WS_WTQ), TT, DM, DM}; pg8::StaticOrder S; S.init(TT, DM, gridDim.x, blockIdx.x);
        pg8::EpiBf16 E{(bf16_t*)(p.ws + WS_D), DM}; pg8::gemm_phase((LAS unsigned char*)smem, g, S, E); }
    SEAM(8);
#ifndef REP9
#define REP9 1
#endif
    if (IN(9)) phase_peer(p, smem, xbar);
#undef IN
#undef SEAM
}

#ifndef MK_MULTI
#define MK_MULTI 0
#endif
extern "C" void kernel_launch(void* const* d_in, const int* in_sizes, int n_in, void* d_out, int out_size, void* d_ws, size_t ws_size, hipStream_t stream) {
    static int grid = 0;
    if (grid == 0) {
        if (n_in != 23 || ws_size < WS_END) { fprintf(stderr, "kernel_launch: n_in %d ws %zu (need %zu)\n", n_in, ws_size, (size_t)WS_END); grid = -1; return; }
        if (hipFuncSetAttribute((const void*)fwd_megakernel, hipFuncAttributeMaxDynamicSharedMemorySize, LDS_BYTES) != hipSuccess) { fprintf(stderr, "kernel_launch: hipFuncSetAttribute failed\n"); grid = -1; return; }
        int dev = 0, cus = 0, per_cu = 0;
        hipGetDevice(&dev); hipDeviceGetAttribute(&cus, hipDeviceAttributeMultiprocessorCount, dev);
        hipOccupancyMaxActiveBlocksPerMultiprocessor(&per_cu, (const void*)fwd_megakernel, NTHREADS, LDS_BYTES);
        if (per_cu < 1) { fprintf(stderr, "kernel_launch: occupancy query says %d blocks/CU\n", per_cu); per_cu = 1; }
        grid = cus;
        if (grid > 256) grid = 256;
        if (TT % grid != 0) { fprintf(stderr, "kernel_launch: grid %d does not divide %d tokens\n", grid, TT); grid = -1; return; }
    }
    if (grid < 0) return;
    (void)hipMemsetAsync((char*)d_ws + WS_MOD, 0, 3 * 12288 * 4 + XCD_BAR_WORDS * 4, stream);
    Params p{};
    p.x_prompt = (const float*)d_in[0]; p.x_sample = (const float*)d_in[1]; p.state_ret = (const float*)d_in[2]; p.cache_k = (const float*)d_in[3]; p.cache_v = (const float*)d_in[4];
    p.c = (const float*)d_in[5]; p.c_ctx = (const float*)d_in[6]; p.w_ada = (const float*)d_in[7]; p.b_ada = (const float*)d_in[8]; p.w_in = (const float*)d_in[9]; p.decay = (const float*)d_in[10];
    p.gn_g = (const float*)d_in[11]; p.qn_g = (const float*)d_in[12]; p.kn_g = (const float*)d_in[13]; p.w_o = (const float*)d_in[14]; p.ln1_g = (const float*)d_in[15]; p.ln1_b = (const float*)d_in[16];
    p.w_q = (const float*)d_in[17]; p.sub_keys = (const float*)d_in[18]; p.peer_u = (const float*)d_in[19]; p.peer_v = (const float*)d_in[20]; p.ln2_g = (const float*)d_in[21]; p.ln2_b = (const float*)d_in[22];
    p.out = (float*)d_out; p.ws = (unsigned char*)d_ws;
    for (int i = 0; i < 10; ++i) p.rep[i] = 1;
#ifdef REPX
    p.rep[REPX] = 2;
#endif
#if MK_MULTI
    for (int ph = 0; ph < 10; ++ph) { p.ph_lo = ph; p.ph_hi = ph + 1; hipLaunchKernelGGL(fwd_megakernel, dim3(grid), dim3(NTHREADS), LDS_BYTES, stream, p); }
#else
    p.ph_lo = 0; p.ph_hi = 10;
    void* args[] = {&p};
    hipError_t e = hipLaunchCooperativeKernel((const void*)fwd_megakernel, dim3(grid), dim3(NTHREADS), args, LDS_BYTES, stream);
    if (e != hipSuccess) fprintf(stderr, "kernel_launch: cooperative launch failed: %s (grid %d)\n", hipGetErrorString(e), grid);
#endif
}
```
